# Optimizing an MI355X kernel written in HIP

```python
import math
import jax, jax.numpy as jnp
from jax import lax
import numpy as np

D_MODEL = 1024
BATCH = 8
SEQ = 4096
DEPTH = 2

N_MIXERS = 2
DN_HEADS = 8
DN_HEAD_DIM = 128
DN_DIM = DN_HEADS * DN_HEAD_DIM
DN_CONV = 4
DN_CHUNK = 64
DN_IN = 4 * DN_DIM + 2 * DN_HEADS
MB_HEADS = 8
MB_HEAD_DIM = D_MODEL // MB_HEADS
MB_DIM = MB_HEADS * MB_HEAD_DIM
MB_BLOCK = 256
MB_TOPK = 3
MB_QCHUNK = 16
D_FF = 4 * D_MODEL
RMS_EPS = 1e-6
N_DN_LAYERS = (DEPTH + 1) // 2
N_MB_LAYERS = DEPTH // 2

kernel_name = "hybrid_gdn_moba_alibi_sqrelu"


def rmsnorm(x, g):
    xf = x.astype(jnp.float32)
    y = xf * lax.rsqrt(jnp.mean(xf * xf, axis=-1, keepdims=True) + RMS_EPS)
    return (y * g.astype(jnp.float32)).astype(x.dtype)


def l2norm(x):
    xf = x.astype(jnp.float32)
    return xf * lax.rsqrt(jnp.sum(xf * xf, axis=-1, keepdims=True) + 1e-6)


def causal_depthwise_conv(x, w):
    k_w = w.shape[0]
    t = x.shape[1]
    xp = jnp.pad(x, ((0, 0), (k_w - 1, 0), (0, 0)))
    y = xp[:, 0:t] * w[0]
    for j in range(1, k_w):
        y = y + xp[:, j:j + t] * w[j]
    return y


def alibi_slopes(n_heads):
    return jnp.exp2(-8.0 * jnp.arange(1, n_heads + 1, dtype=jnp.float32) / n_heads)


def chunk_gated_delta_rule(q, k, v, g, beta):
    b, h, t, dk = q.shape
    dv = v.shape[-1]
    c = DN_CHUNK
    n = t // c
    q = q.astype(jnp.float32).reshape(b, h, n, c, dk)
    k = k.astype(jnp.float32).reshape(b, h, n, c, dk)
    v = v.astype(jnp.float32).reshape(b, h, n, c, dv)
    g = g.astype(jnp.float32).reshape(b, h, n, c)
    beta = beta.astype(jnp.float32).reshape(b, h, n, c)

    gc = jnp.cumsum(g, axis=-1)
    idx = jnp.arange(c)
    tri_incl = idx[:, None] >= idx[None, :]
    tri_strict = idx[:, None] > idx[None, :]
    decay = jnp.exp(jnp.where(tri_incl, gc[..., :, None] - gc[..., None, :], -jnp.inf))

    k_beta = k * beta[..., None]
    a_low = jnp.where(tri_strict, jnp.einsum('bhncd,bhnsd->bhncs', k_beta, k) * decay, 0.0)
    a_mat = a_low + jnp.eye(c, dtype=jnp.float32)
    rhs = jnp.concatenate([v * beta[..., None], k_beta * jnp.exp(gc)[..., None]], axis=-1)
    sol = lax.linalg.triangular_solve(a_mat, rhs, left_side=True, lower=True, unit_diagonal=True)
    u, w = sol[..., :dv], sol[..., dv:]

    attn_intra = jnp.einsum('bhncd,bhnsd->bhncs', q, k) * decay
    q_dec = q * jnp.exp(gc)[..., None]
    k_dec = k * jnp.exp(gc[..., -1:] - gc)[..., None]
    g_tot = jnp.exp(gc[..., -1])

    xs = tuple(jnp.moveaxis(a, 2, 0) for a in (u, w, q_dec, k_dec, attn_intra, g_tot))

    def step(state, inp):
        u_c, w_c, qd_c, kd_c, at_c, gt_c = inp
        v_new = u_c - jnp.einsum('bhcd,bhde->bhce', w_c, state)
        o_c = jnp.einsum('bhcd,bhde->bhce', qd_c, state) + jnp.einsum('bhcs,bhse->bhce', at_c, v_new)
        state = state * gt_c[..., None, None] + jnp.einsum('bhcd,bhce->bhde', kd_c, v_new)
        return state, o_c

    s0 = jnp.zeros((b, h, dk, dv), jnp.float32)
    _, o = lax.scan(step, s0, xs)
    return jnp.moveaxis(o, 0, 2).reshape(b, h, t, dv)


def gated_deltanet(hn, w_in, conv_w, a_log, dt_bias, out_norm_g, w_out):
    b, t, _ = hn.shape
    proj = hn @ w_in
    qkv = jax.nn.silu(causal_depthwise_conv(proj[..., :3 * DN_DIM], conv_w))
    z = proj[..., 3 * DN_DIM:4 * DN_DIM]
    b_raw = proj[..., 4 * DN_DIM:4 * DN_DIM + DN_HEADS].astype(jnp.float32)
    a_raw = proj[..., 4 * DN_DIM + DN_HEADS:].astype(jnp.float32)

    def heads(a):
        return a.reshape(b, t, DN_HEADS, DN_HEAD_DIM).transpose(0, 2, 1, 3)

    q = heads(l2norm(heads(qkv[..., :DN_DIM]).transpose(0, 2, 1, 3)) * DN_HEAD_DIM ** -0.5)
    k = heads(l2norm(heads(qkv[..., DN_DIM:2 * DN_DIM]).transpose(0, 2, 1, 3)))
    v = heads(qkv[..., 2 * DN_DIM:])
    beta = jax.nn.sigmoid(b_raw).transpose(0, 2, 1)
    g = (-jnp.exp(a_log.astype(jnp.float32)) *
         jax.nn.softplus(a_raw + dt_bias.astype(jnp.float32))).transpose(0, 2, 1)
    o = chunk_gated_delta_rule(q, k, v, g, beta)
    o = o.transpose(0, 2, 1, 3).astype(hn.dtype)
    o = rmsnorm(o, out_norm_g) * jax.nn.silu(z.reshape(b, t, DN_HEADS, DN_HEAD_DIM))
    return o.reshape(b, t, DN_DIM) @ w_out


def moba_attention(q, k, v):
    b, h, t, dh = q.shape
    nb = -(-t // MB_BLOCK)
    tp = nb * MB_BLOCK
    pad = ((0, 0), (0, 0), (0, tp - t), (0, 0))
    q, k, v = jnp.pad(q, pad), jnp.pad(k, pad), jnp.pad(v, pad)
    kb = k.reshape(b, h, nb, MB_BLOCK, dh)
    vb = v.reshape(b, h, nb, MB_BLOCK, dh)
    top = min(MB_TOPK, nb)
    scale = dh ** -0.5
    slopes = alibi_slopes(h)

    k_mean = jnp.mean(kb.astype(jnp.float32), axis=3)
    gate = jnp.einsum('bhtd,bhnd->bhtn', q.astype(jnp.float32), k_mean)
    q_blk = jnp.arange(tp) // MB_BLOCK
    past = jnp.arange(nb)[None, :] < q_blk[:, None]
    gate = jnp.where(past, gate, -jnp.inf)
    _, sel = lax.top_k(gate, top)
    valid = sel < q_blk[:, None]

    n_qc = tp // MB_QCHUNK

    def to_chunks(a):
        return jnp.moveaxis(a.reshape(b, h, n_qc, MB_QCHUNK, *a.shape[3:]), 2, 0)

    gather_blocks = jax.vmap(jax.vmap(lambda blocks, ids: blocks[ids]))

    def attend_chunk(args):
        qc, selc, validc, ci = args
        t0 = ci * MB_QCHUNK
        blk = t0 // MB_BLOCK
        tpos = (t0 + jnp.arange(MB_QCHUNK)).astype(jnp.float32)
        ks = gather_blocks(kb, selc)
        vs = gather_blocks(vb, selc)
        s_sel = jnp.einsum('bhqd,bhqnld->bhqnl', qc, ks).astype(jnp.float32) * scale
        kpos_sel = (selc[..., None] * MB_BLOCK + jnp.arange(MB_BLOCK)).astype(jnp.float32)
        dist_sel = tpos[:, None, None] - kpos_sel
        s_sel = jnp.where(validc[..., None], s_sel - slopes[:, None, None, None] * dist_sel, -jnp.inf)
        ko = lax.dynamic_index_in_dim(kb, blk, axis=2, keepdims=False)
        vo = lax.dynamic_index_in_dim(vb, blk, axis=2, keepdims=False)
        s_own = jnp.einsum('bhqd,bhld->bhql', qc, ko).astype(jnp.float32) * scale
        dist_own = tpos[:, None] - (blk * MB_BLOCK + jnp.arange(MB_BLOCK)).astype(jnp.float32)
        s_own = jnp.where(dist_own >= 0, s_own - slopes[:, None, None] * dist_own, -jnp.inf)
        logits = jnp.concatenate([s_sel.reshape(b, h, MB_QCHUNK, top * MB_BLOCK), s_own], axis=-1)
        p = jax.nn.softmax(logits, axis=-1).astype(vs.dtype)
        p_sel = p[..., :top * MB_BLOCK].reshape(b, h, MB_QCHUNK, top, MB_BLOCK)
        p_own = p[..., top * MB_BLOCK:]
        return (jnp.einsum('bhqnl,bhqnld->bhqd', p_sel, vs) +
                jnp.einsum('bhql,bhld->bhqd', p_own, vo))

    out = lax.map(attend_chunk, (to_chunks(q), to_chunks(sel), to_chunks(valid), jnp.arange(n_qc)))
    out = jnp.moveaxis(out, 0, 2).reshape(b, h, tp, dh)
    return out[:, :, :t]


def moba_layer(hn, w_in, w_out):
    b, t, _ = hn.shape
    proj = hn @ w_in

    def heads(a):
        return a.reshape(b, t, MB_HEADS, MB_HEAD_DIM).transpose(0, 2, 1, 3)

    q = heads(proj[..., :MB_DIM])
    k = heads(proj[..., MB_DIM:2 * MB_DIM])
    v = heads(proj[..., 2 * MB_DIM:])
    o = moba_attention(q, k, v)
    return o.transpose(0, 2, 1, 3).reshape(b, t, MB_DIM) @ w_out


def squared_relu_mlp(hn, w_up, w_down):
    return jnp.square(jax.nn.relu(hn @ w_up)) @ w_down


def setup_inputs(seed: int = 0) -> dict:
    key = jax.random.key(seed)
    ks = jax.random.split(key, 16)
    f32 = jnp.float32
    x = jax.random.normal(ks[0], (BATCH, SEQ, D_MODEL), f32)
    mix_norm_g = 1.0 + 0.02 * jax.random.normal(ks[1], (DEPTH, D_MODEL), f32)
    mlp_norm_g = 1.0 + 0.02 * jax.random.normal(ks[2], (DEPTH, D_MODEL), f32)
    dn_w_in = jax.random.normal(ks[3], (N_DN_LAYERS, D_MODEL, DN_IN), f32) * D_MODEL ** -0.5
    dn_conv_w = jax.random.normal(ks[4], (N_DN_LAYERS, DN_CONV, 3 * DN_DIM), f32) * DN_CONV ** -0.5
    dn_a_log = jnp.log(jax.random.uniform(ks[5], (N_DN_LAYERS, DN_HEADS), f32, 1.0, 16.0))
    dt = jnp.exp(jax.random.uniform(ks[6], (N_DN_LAYERS, DN_HEADS), f32, math.log(1e-3), math.log(1e-1)))
    dn_dt_bias = dt + jnp.log(-jnp.expm1(-dt))
    dn_out_norm_g = 1.0 + 0.02 * jax.random.normal(ks[7], (N_DN_LAYERS, DN_HEAD_DIM), f32)
    dn_w_out = jax.random.normal(ks[8], (N_DN_LAYERS, DN_DIM, D_MODEL), f32) * DN_DIM ** -0.5
    mb_w_in = jax.random.normal(ks[9], (N_MB_LAYERS, D_MODEL, 3 * MB_DIM), f32) * D_MODEL ** -0.5
    mb_w_out = jax.random.normal(ks[10], (N_MB_LAYERS, MB_DIM, D_MODEL), f32) * MB_DIM ** -0.5
    mlp_w_up = jax.random.normal(ks[11], (DEPTH, D_MODEL, D_FF), f32) * D_MODEL ** -0.5
    mlp_w_down = jax.random.normal(ks[12], (DEPTH, D_FF, D_MODEL), f32) * D_FF ** -0.5
    final_norm_g = 1.0 + 0.02 * jax.random.normal(ks[13], (D_MODEL,), f32)
    return {"x": x, "mix_norm_g": mix_norm_g, "mlp_norm_g": mlp_norm_g,
            "dn_w_in": dn_w_in, "dn_conv_w": dn_conv_w, "dn_a_log": dn_a_log,
            "dn_dt_bias": dn_dt_bias, "dn_out_norm_g": dn_out_norm_g, "dn_w_out": dn_w_out,
            "mb_w_in": mb_w_in, "mb_w_out": mb_w_out,
            "mlp_w_up": mlp_w_up, "mlp_w_down": mlp_w_down, "final_norm_g": final_norm_g}


def reference(x, mix_norm_g, mlp_norm_g, dn_w_in, dn_conv_w, dn_a_log, dn_dt_bias,
              dn_out_norm_g, dn_w_out, mb_w_in, mb_w_out, mlp_w_up, mlp_w_down, final_norm_g):
    h = x
    for i in range(DEPTH):
        hn = rmsnorm(h, mix_norm_g[i])
        j = i // N_MIXERS
        if i % N_MIXERS == 0:
            mix = gated_deltanet(hn, dn_w_in[j], dn_conv_w[j], dn_a_log[j], dn_dt_bias[j],
                                 dn_out_norm_g[j], dn_w_out[j])
        else:
            mix = moba_layer(hn, mb_w_in[j], mb_w_out[j])
        h = h + mix.astype(h.dtype)
        h = h + squared_relu_mlp(rmsnorm(h, mlp_norm_g[i]), mlp_w_up[i], mlp_w_down[i])
    return rmsnorm(h, final_norm_g)
```

```cpp
#include <hip/hip_runtime.h>
#include <cstdio>
#include <cstdint>
#include <cmath>
#define USE_REF_DELTA 1
#define MK_ONE_LAUNCH 0
namespace pg8 {
#define PG8_LAS __attribute__((address_space(3)))
typedef unsigned short bf16_t;
typedef short bf16x8 __attribute__((ext_vector_type(8)));
typedef float f32x4 __attribute__((ext_vector_type(4)));
typedef unsigned u32x4 __attribute__((ext_vector_type(4)));
constexpr int BM = 256, BK = 64, HALF = 128, HTB = HALF * BK * 2  , STAGE_BYTES = 8 * HTB, NXCD = 8, WGM = 8;

__host__ __device__ __forceinline__ int lds_byte(int r, int c) { const int st = (r >> 4) * 2 + (c >> 5), rr = r & 15, cc = c & 31, ob = rr * 64 + cc * 2; return st * 1024 + (ob ^ (((ob >> 9) & 1) << 5)); }
__host__ __device__ __forceinline__ void stage_rc(int b, int& R, int& C) { const int st = b / 1024, sb = b % 1024, swz = sb ^ (((sb >> 9) & 1) << 5); R = (st >> 1) * 16 + swz / 64; C = (st & 1) * 32 + (swz % 64) / 2; }
__host__ __device__ __forceinline__ int perm32(int rho) { const int n = rho >> 4, i = rho & 15; return 8 * (i >> 2) + 4 * n + (i & 3); }

struct Unit { int pm, pn; };
struct Gemm { const bf16_t* A; const bf16_t* Bt; int M, N, K; };

struct StaticOrder {
    int nM, nN, nwg, G, c;
    __host__ __device__ void init(int M, int N, int G_, int c_) { nM = M / BM; nN = N / BM; nwg = nM * nN; G = G_; c = c_; }
    __host__ __device__ bool next(int i, Unit& u) const {
        const long L = (long)i * G + c; if (L >= nwg) return false;
        int wgid = (int)L; { const int q = nwg / NXCD, r = nwg % NXCD, xcd = wgid % NXCD, off = wgid / NXCD; wgid = (xcd < r ? xcd * (q + 1) : r * (q + 1) + (xcd - r) * q) + off; }
        const int nig = WGM * nN, gid = wgid / nig, fm = gid * WGM, gsz = (nM - fm) < WGM ? (nM - fm) : WGM;
        u.pm = fm + ((wgid % nig) % gsz); u.pn = (wgid % nig) / gsz; return true;
    }
    __device__ __forceinline__ void a_ready(const Unit&) const {}
    __device__ __forceinline__ void done(const Unit&) const {}
};

__device__ __forceinline__ unsigned cvt_pk_bf16(float lo, float hi) { unsigned r; asm volatile("v_cvt_pk_bf16_f32 %0, %1, %2" : "=v"(r) : "v"(lo), "v"(hi)); return r; }
typedef float f32x2 __attribute__((ext_vector_type(2)));
template <class Epi, class Sched, bool ALIGN_EPI = false, bool SP2 = false>
__device__ __forceinline__ void gemm_phase(PG8_LAS unsigned char* lds, const Gemm g, const Sched& S, const Epi& E) {
    const int tid = threadIdx.x, wid = __builtin_amdgcn_readfirstlane(tid >> 6), lane = tid & 63, wr = wid >> 2, wc = wid & 3, fr = lane & 15, fq = lane >> 4;
    const int K = g.K, nt = K / BK;
    unsigned voffA[2], voffB[2];
#pragma unroll
    for (int i = 0; i < 2; ++i) { int R, C; stage_rc(tid * 16 + i * 8192, R, C); const int Rb = Epi::PERM ? ((R & ~31) + perm32(R & 31)) : R;
        voffA[i] = (unsigned)(R * K + C) * 2u; voffB[i] = (unsigned)(Rb * K + C) * 2u; }
    const size_t kstep = (size_t)(BK * 2);
    const size_t hstep = (size_t)HALF * K * 2;
    const size_t tstep = 2 * hstep;
    const unsigned ldsw = (unsigned)wid * 1024u;
    const int aoff = lds_byte(wr * 64 + fr, fq * 8), boff = lds_byte(wc * 32 + fr, fq * 8);
#define PG8_SA(b, h) (((b) * 2 + (h)) * HTB)
#define PG8_SB(b, h) ((4 + (b) * 2 + (h)) * HTB)
#define PG8_STAGE(bufoff, gbase, voff) do { _Pragma("unroll") for (int _i = 0; _i < 2; ++_i) \
        __builtin_amdgcn_global_load_lds((const unsigned*)((const char*)(gbase) + (voff)[_i]), (PG8_LAS unsigned*)(lds + (bufoff) + ldsw + _i * 8192), 16, 0, 0); } while (0)
#define PG8_LDA(dst, b, h) do { _Pragma("unroll") for (int m = 0; m < 4; ++m) _Pragma("unroll") for (int k = 0; k < 2; ++k) dst[m][k] = *(const PG8_LAS bf16x8*)(lds + PG8_SA(b, h) + aoff + m * 2048 + k * 1024); } while (0)
#define PG8_LDB(dst, b, h) do { _Pragma("unroll") for (int n = 0; n < 2; ++n) _Pragma("unroll") for (int k = 0; k < 2; ++k) dst[n][k] = *(const PG8_LAS bf16x8*)(lds + PG8_SB(b, h) + boff + n * 2048 + k * 1024); } while (0)
#define PG8_MMA(ai, bj, At, Bt) do { __builtin_amdgcn_s_setprio(1); _Pragma("unroll") for (int m = 0; m < 4; ++m) _Pragma("unroll") for (int n = 0; n < 2; ++n) _Pragma("unroll") for (int k = 0; k < 2; ++k) \
        acc[ai][bj][m][n] = __builtin_amdgcn_mfma_f32_16x16x32_bf16(Bt[n][k], At[m][k], acc[ai][bj][m][n], 0, 0, 0); __builtin_amdgcn_s_setprio(0); } while (0)
#define PG8_WAIT_V(n) asm volatile("s_waitcnt vmcnt(" #n ")" ::: "memory")
#define PG8_WAIT_L(n) asm volatile("s_waitcnt lgkmcnt(" #n ")" ::: "memory")
#define PG8_BAR __builtin_amdgcn_s_barrier()
#define PG8_SCHED __builtin_amdgcn_sched_barrier(0)
    Unit cur, nxt; int ui = 0;
    if (!S.next(0, cur)) return;
    f32x4 acc[2][2][4][2];
#pragma unroll
    for (int a = 0; a < 2; ++a)
#pragma unroll
        for (int b = 0; b < 2; ++b)
#pragma unroll
            for (int m = 0; m < 4; ++m)
#pragma unroll
                for (int n = 0; n < 2; ++n) acc[a][b][m][n] = (f32x4){0.f, 0.f, 0.f, 0.f};
    bf16x8 At[4][2], B0[2][2], B1[2][2];
    const char* cA = (const char*)g.A + (size_t)cur.pm * tstep; const char* cB = (const char*)g.Bt + (size_t)cur.pn * tstep;
    S.a_ready(cur);
    if constexpr (SP2) {
        PG8_STAGE(PG8_SB(0, 0), cB, voffB); PG8_STAGE(PG8_SB(0, 1), cB + hstep, voffB); PG8_STAGE(PG8_SA(0, 0), cA, voffA); PG8_STAGE(PG8_SA(0, 1), cA + hstep, voffA);
        if (wr == 1) PG8_BAR;
        PG8_WAIT_V(2); PG8_BAR;
        PG8_STAGE(PG8_SB(1, 0), cB + kstep, voffB); PG8_STAGE(PG8_SA(1, 0), cA + kstep, voffA); PG8_STAGE(PG8_SB(1, 1), cB + hstep + kstep, voffB);
        PG8_WAIT_V(6); PG8_BAR;
    } else {
        PG8_STAGE(PG8_SB(0, 0), cB, voffB); PG8_STAGE(PG8_SA(0, 0), cA, voffA); PG8_STAGE(PG8_SB(0, 1), cB + hstep, voffB); PG8_STAGE(PG8_SA(0, 1), cA + hstep, voffA);
        if (wr == 1) PG8_BAR;
        PG8_WAIT_V(4); PG8_BAR;
        PG8_STAGE(PG8_SB(1, 0), cB + kstep, voffB); PG8_STAGE(PG8_SA(1, 0), cA + kstep, voffA); PG8_STAGE(PG8_SB(1, 1), cB + hstep + kstep, voffB);
        PG8_WAIT_V(6); PG8_BAR;
    }
    for (;;) {
        const bool has_next = S.next(ui + 1, nxt);
        const char* nA = has_next ? (const char*)g.A + (size_t)nxt.pm * tstep : cA; const char* nB = has_next ? (const char*)g.Bt + (size_t)nxt.pn * tstep : cB;
        for (int t = 0; t < nt; t += 2) {
            const bool last = (t == nt - 2);
            const char* a1 = cA + (size_t)(t + 1) * kstep;
            const char* a2 = last ? nA : cA + (size_t)(t + 2) * kstep; const char* b2 = last ? nB : cB + (size_t)(t + 2) * kstep;
            const char* a3 = a2 + kstep; const char* b3 = b2 + kstep;
            if (last && has_next) S.a_ready(nxt);
            if constexpr (SP2) {
            PG8_LDB(B0, 0, 0); PG8_LDB(B1, 0, 1); PG8_SCHED; PG8_LDA(At, 0, 0); PG8_STAGE(PG8_SA(1, 1), a1 + hstep, voffA);
            PG8_WAIT_V(8); PG8_WAIT_L(0); PG8_BAR; PG8_MMA(0, 0, At, B0); PG8_MMA(0, 1, At, B1); PG8_BAR; PG8_SCHED;
            PG8_LDA(At, 0, 1); PG8_STAGE(PG8_SB(0, 0), b2, voffB); PG8_STAGE(PG8_SB(0, 1), b2 + hstep, voffB); PG8_STAGE(PG8_SA(0, 0), a2, voffA);
            PG8_WAIT_V(8); PG8_WAIT_L(0); PG8_BAR; PG8_MMA(1, 0, At, B0); PG8_MMA(1, 1, At, B1); PG8_BAR; PG8_SCHED;
            PG8_LDB(B0, 1, 0); PG8_LDB(B1, 1, 1); PG8_SCHED; PG8_LDA(At, 1, 0); PG8_STAGE(PG8_SA(0, 1), a2 + hstep, voffA);
            PG8_WAIT_V(8); PG8_WAIT_L(0); PG8_BAR; PG8_MMA(0, 0, At, B0); PG8_MMA(0, 1, At, B1); PG8_BAR; PG8_SCHED;
            PG8_LDA(At, 1, 1); PG8_STAGE(PG8_SB(1, 0), b3, voffB); PG8_STAGE(PG8_SB(1, 1), b3 + hstep, voffB); PG8_STAGE(PG8_SA(1, 0), a3, voffA);
            PG8_WAIT_V(8); PG8_WAIT_L(0); PG8_BAR; PG8_MMA(1, 0, At, B0); PG8_MMA(1, 1, At, B1); PG8_BAR; PG8_SCHED;
            } else {
            PG8_LDB(B0, 0, 0); PG8_SCHED; PG8_LDA(At, 0, 0); PG8_STAGE(PG8_SA(1, 1), a1 + hstep, voffA);
            PG8_WAIT_L(8); PG8_BAR; PG8_WAIT_L(0); PG8_MMA(0, 0, At, B0); PG8_BAR; PG8_SCHED;
            PG8_LDB(B1, 0, 1); PG8_STAGE(PG8_SB(0, 0), b2, voffB);
            PG8_BAR; PG8_WAIT_L(0); PG8_MMA(0, 1, At, B1); PG8_BAR;
            PG8_LDA(At, 0, 1); PG8_STAGE(PG8_SA(0, 0), a2, voffA);
            PG8_BAR; PG8_WAIT_L(0); PG8_MMA(1, 0, At, B0); PG8_BAR; PG8_SCHED;
            PG8_STAGE(PG8_SB(0, 1), b2 + hstep, voffB);
            PG8_WAIT_V(6); PG8_BAR; PG8_MMA(1, 1, At, B1); PG8_BAR;
            PG8_LDB(B0, 1, 0); PG8_SCHED; PG8_LDA(At, 1, 0); PG8_STAGE(PG8_SA(0, 1), a2 + hstep, voffA);
            PG8_WAIT_L(8); PG8_BAR; PG8_WAIT_L(0); PG8_MMA(0, 0, At, B0); PG8_BAR; PG8_SCHED;
            PG8_LDB(B1, 1, 1); PG8_STAGE(PG8_SB(1, 0), b3, voffB);
            PG8_BAR; PG8_WAIT_L(0); PG8_MMA(0, 1, At, B1); PG8_BAR;
            PG8_LDA(At, 1, 1); PG8_STAGE(PG8_SA(1, 0), a3, voffA);
            PG8_BAR; PG8_WAIT_L(0); PG8_MMA(1, 0, At, B0); PG8_BAR; PG8_SCHED;
            PG8_STAGE(PG8_SB(1, 1), b3 + hstep, voffB);
            PG8_WAIT_V(6); PG8_BAR; PG8_MMA(1, 1, At, B1); PG8_BAR;
            }
        }
        if constexpr (ALIGN_EPI) { if (wr == 0) PG8_BAR; }
        if constexpr (!Epi::AFTER_DRAIN) { E(acc, cur, wr, wc, fr, fq); S.done(cur); }
        if (!has_next) break;
#pragma unroll
        for (int a = 0; a < 2; ++a)
#pragma unroll
            for (int b = 0; b < 2; ++b)
#pragma unroll
                for (int m = 0; m < 4; ++m)
#pragma unroll
                    for (int n = 0; n < 2; ++n) acc[a][b][m][n] = (f32x4){0.f, 0.f, 0.f, 0.f};
        cur = nxt; cA = nA; cB = nB; ++ui;
        if constexpr (ALIGN_EPI) { if (wr == 1) PG8_BAR; }
    }
    PG8_WAIT_V(0);
    if constexpr (!ALIGN_EPI) { if (wr == 0) PG8_BAR; }
    PG8_BAR;
    if constexpr (Epi::AFTER_DRAIN) { E.fused(acc, cur, wr, wc, fr, fq, lds, wid, lane); S.done(cur); }
#undef PG8_SA
#undef PG8_SB
#undef PG8_STAGE
#undef PG8_LDA
#undef PG8_LDB
#undef PG8_MMA
#undef PG8_WAIT_V
#undef PG8_WAIT_L
#undef PG8_BAR
#undef PG8_SCHED
}
}
#define GAS __attribute__((address_space(1)))
#define LAS __attribute__((address_space(3)))
typedef unsigned short bf16;
typedef unsigned v4u __attribute__((ext_vector_type(4)));
typedef float f32x4 __attribute__((ext_vector_type(4)));
typedef short bf16x8 __attribute__((ext_vector_type(8)));
typedef GAS unsigned gu32;
typedef GAS unsigned long long gu64;
#define RLX_AGENT __ATOMIC_RELAXED, __HIP_MEMORY_SCOPE_AGENT
#define LDS_WAIT() asm volatile("s_waitcnt lgkmcnt(0)" ::: "memory")
#define VM_WAIT() asm volatile("s_waitcnt vmcnt(0)" ::: "memory")
__device__ __forceinline__ unsigned long long rt() { return __builtin_amdgcn_s_memrealtime(); }
__device__ __forceinline__ unsigned f2bf(float f) { unsigned u = __builtin_bit_cast(unsigned, f); return (u + 0x7fffu + ((u >> 16) & 1u)) >> 16; }
__device__ __forceinline__ unsigned pk2(float lo, float hi) { return f2bf(lo) | (f2bf(hi) << 16); }

#define XB_TMO      128
#define XB_XCNT(j)  (256  + 64 * (j))
#define XB_XSUB(j)  (1280 + 64 * (j))
#define XB_XGEN(j)  (2304 + 64 * (j))
#define XB_TOP      3328
#define XB_TOPGEN   3392
#define XCD_BAR_WORDS 3456
#define XB_SPIN_CAP (1u << 18)

__device__ __forceinline__ unsigned xb_ld(unsigned* p)              { return __hip_atomic_load(p, __ATOMIC_RELAXED, __HIP_MEMORY_SCOPE_AGENT); }
__device__ __forceinline__ unsigned xb_add(unsigned* p, unsigned v) { return __hip_atomic_fetch_add(p, v, __ATOMIC_RELAXED, __HIP_MEMORY_SCOPE_AGENT); }
__device__ __forceinline__ unsigned xb_xcc_id() { return (unsigned)__builtin_amdgcn_s_getreg((3 << 11) | 20) & 0xFu; }
#define XB_SPIN(cond, bar) do { unsigned _sp = 0; while (cond) { __builtin_amdgcn_s_sleep(1); \
    if ((++_sp & 255u) == 0u) { if (xb_ld(&(bar)[XB_TMO])) break; if (_sp > XB_SPIN_CAP) { atomicAdd(&(bar)[XB_TMO], 1u); break; } } } } while (0)

struct XcdBarrier {
    unsigned* bar; unsigned x;
    volatile LAS unsigned* st;
};

__device__ __forceinline__ XcdBarrier xcd_barrier_post(unsigned* bar, volatile LAS unsigned* st) {
    XcdBarrier b; b.bar = bar; b.x = xb_xcc_id(); b.st = st;
    if (threadIdx.x == 0) (void)xb_add(&bar[XB_XCNT(b.x)], 1u);
    return b;
}
__device__ __forceinline__ void xcd_barrier_complete(unsigned* bar, unsigned x, unsigned& nloc, unsigned& nx) {
    const unsigned G = gridDim.x * gridDim.y * gridDim.z;
    unsigned sum, cnt, mine, sp = 0u;
    for (;;) {
        sum = 0u; cnt = 0u; mine = 0u;
#pragma unroll
        for (unsigned j = 0; j < 16; ++j) { const unsigned c = xb_ld(&bar[XB_XCNT(j)]); sum += c; cnt += (c > 0u) ? 1u : 0u; mine = (j == x) ? c : mine; }
        if (sum == G) break;
        __builtin_amdgcn_s_sleep(1);
        if ((++sp & 255u) == 0u) { if (xb_ld(&bar[XB_TMO])) break; if (sp > XB_SPIN_CAP) { atomicAdd(&bar[XB_TMO], 1u); break; } }
    }
    nloc = mine > 0u ? mine : 1u; nx = cnt > 0u ? cnt : 1u;
}

__device__ __forceinline__ void xcd_barrier(const XcdBarrier& b) {
    asm volatile("s_waitcnt vmcnt(0)" ::: "memory");
    __syncthreads();
    if (threadIdx.x == 0) {
        unsigned* bar = b.bar;
        __builtin_amdgcn_s_waitcnt(0);
        unsigned nloc = b.st[0], nx = b.st[1];
        if (nloc == 0u) { xcd_barrier_complete(bar, b.x, nloc, nx); b.st[0] = nloc; b.st[1] = nx; }
        const unsigned old = xb_add(&bar[XB_XSUB(b.x)], 1u);
        const unsigned gen = old / nloc;
        if (old + 1u == (gen + 1u) * nloc) {
            __builtin_amdgcn_fence(__ATOMIC_RELEASE, "agent");
            asm volatile("s_waitcnt vmcnt(0)" ::: "memory");
            const unsigned og = xb_add(&bar[XB_TOP], 1u);
            const unsigned tg = og / nx;
            if (og + 1u == (tg + 1u) * nx) xb_add(&bar[XB_TOPGEN], 1u);
            else XB_SPIN(xb_ld(&bar[XB_TOPGEN]) == tg, bar);
            __builtin_amdgcn_fence(__ATOMIC_ACQUIRE, "agent");
            xb_add(&bar[XB_XGEN(b.x)], 1u);
            asm volatile("s_waitcnt vmcnt(0)" ::: "memory");
        } else {
            XB_SPIN(xb_ld(&bar[XB_XGEN(b.x)]) == gen, bar);
            __builtin_amdgcn_fence(__ATOMIC_ACQUIRE, "agent");
            asm volatile("s_waitcnt vmcnt(0)" ::: "memory");
        }
    }
    __syncthreads();
}

#define DI __device__ __forceinline__
typedef float f32x16 __attribute__((ext_vector_type(16)));
typedef short s16x4 __attribute__((ext_vector_type(4)));
typedef unsigned u32x2 __attribute__((ext_vector_type(2)));
typedef float f32x2_t __attribute__((ext_vector_type(2)));
typedef __bf16 bf16x2_t __attribute__((ext_vector_type(2)));
#define MFMA32(a, b, c) __builtin_amdgcn_mfma_f32_32x32x16_bf16((a), (b), (c), 0, 0, 0)
#define MFMA16(a, b, c) __builtin_amdgcn_mfma_f32_16x16x32_bf16((a), (b), (c), 0, 0, 0)

constexpr int BATCH = 8, T = 4096, D = 1024, H = 8, HD = 128, FF = 4096;
constexpr int M = BATCH * T;
constexpr int NDN = 4 * D + 2 * H;
constexpr int NDN_PAD = 4352;
constexpr int NMB = 3 * D;
constexpr int CL = 64, NCH = T / CL;
constexpr float RMS_EPS = 1e-6f;
constexpr int NWAVES = 8;
constexpr float LOG2E = 1.4426950408889634f;
constexpr float QSCALE = 0.08838834764831845f * LOG2E;

constexpr size_t MiB = 1u << 20;
constexpr size_t WS_CTL = 0, CTL_ZERO_BYTES = 1 * MiB;
constexpr size_t WS_BETA = 1 * MiB, WS_G = 2 * MiB, WS_KPART = 3 * MiB;
constexpr size_t WS_SSQ = 4 * MiB;
constexpr size_t WS_GTOT = 12 * MiB;
constexpr size_t WS_W = 13 * MiB;
constexpr size_t WS_WDNIN = WS_W, WS_WDNOUT = WS_WDNIN + (size_t)NDN_PAD * D * 2, WS_WUP0 = WS_WDNOUT + (size_t)D * D * 2, WS_WDOWN0 = WS_WUP0 + (size_t)FF * D * 2,
                 WS_WMBIN = WS_WDOWN0 + (size_t)FF * D * 2, WS_WMBOUT = WS_WMBIN + (size_t)NMB * D * 2, WS_WUP1 = WS_WMBOUT + (size_t)D * D * 2, WS_WDOWN1 = WS_WUP1 + (size_t)FF * D * 2,
                 WS_WEND = WS_WDOWN1 + (size_t)FF * D * 2;
static_assert(WS_WEND <= 64 * MiB, "weights fit below 64 MiB");
constexpr size_t WS_Q0 = 64 * MiB;
constexpr size_t WS_K0 = 128 * MiB;
constexpr size_t WS_CH = 192 * MiB;
constexpr size_t WS_END = 480 * MiB;
constexpr size_t CH_BYTES = 73728;
constexpr size_t CH_W = 0, CH_U = 16384, CH_QD = 32768, CH_KD = 49152, CH_AT = 65536;
static_assert(WS_CH + (size_t)BATCH * H * NCH * CH_BYTES <= WS_END, "chunk operand region");

constexpr int CW_TMO = 0, CW_CODE = 1, CW_BAR = 4096;

constexpr int LDS_BYTES = 163840;
constexpr int MISC_OFF = LDS_BYTES - 512;

DI float bf2f(unsigned short b) { return __uint_as_float((unsigned)b << 16); }
DI unsigned cvtpk(float lo, float hi) { f32x2_t v = {lo, hi}; bf16x2_t b = __builtin_convertvector(v, bf16x2_t); return __builtin_bit_cast(unsigned, b); }
DI float wave_sum(float v) {
#pragma unroll
    for (int o = 1; o < 64; o <<= 1) v += __shfl_xor(v, o);
    return v;
}
DI float sigmoidf_(float x) { return 1.f / (1.f + __expf(-x)); }
DI float siluf_(float x) { return x / (1.f + __expf(-x)); }
DI float softplusf_(float x) { return fmaxf(x, 0.f) + log1pf(__expf(-fabsf(x))); }

struct Frame {
    LAS unsigned char* lds;
    volatile LAS unsigned* MISC;
    gu32* ctl;
    int tid, lane, wave;
    int vcu, G;
    const float *x, *mix_g, *mlp_g, *dn_w_in, *dn_conv_w, *dn_a_log, *dn_dt_bias, *dn_out_g, *dn_w_out, *mb_w_in, *mb_w_out, *w_up, *w_down, *final_g;
    float* out; unsigned char* ws;
};

struct EpiDnIn {
    static constexpr bool PERM = true, AFTER_DRAIN = false;
    bf16 *QK0, *ZV0; float *beta, *g; const float *a_log, *dt_bias;
    __device__ __forceinline__ void operator()(const pg8::f32x4 (&acc)[2][2][4][2], const pg8::Unit& u, int wr, int wc, int fr, int fq) const {
        const int row0 = u.pm * 256 + wr * 64 + fr;
        if (u.pn < 16) {
            const int ts = u.pn >> 2; bf16* base = (ts < 2) ? QK0 + (size_t)ts * M * D : ZV0 + (size_t)(3 - ts) * M * D;
            const int col0 = (u.pn & 3) * 256 + wc * 32 + 8 * fq;
#pragma unroll
            for (int ai = 0; ai < 2; ++ai)
#pragma unroll
                for (int m = 0; m < 4; ++m) { bf16* rowp = base + (size_t)(row0 + ai * 128 + m * 16) * D + col0;
#pragma unroll
                    for (int bj = 0; bj < 2; ++bj) { const pg8::f32x4 v0 = acc[ai][bj][m][0], v1 = acc[ai][bj][m][1];
                        v4u w; w.x = cvtpk(v0[0], v0[1]); w.y = cvtpk(v0[2], v0[3]); w.z = cvtpk(v1[0], v1[1]); w.w = cvtpk(v1[2], v1[3]);
                        *(v4u*)(rowp + bj * 128) = w; } }
        } else if (wc == 0 && fq < 2) {
            float al[8], db[8];
#pragma unroll
            for (int i = 0; i < 8; ++i) { al[i] = -__expf(a_log[i]); db[i] = dt_bias[i]; }
#pragma unroll
            for (int ai = 0; ai < 2; ++ai)
#pragma unroll
                for (int m = 0; m < 4; ++m) { const int row = row0 + ai * 128 + m * 16; const pg8::f32x4 v0 = acc[ai][0][m][0], v1 = acc[ai][0][m][1];
                    float v[8] = {v0[0], v0[1], v0[2], v0[3], v1[0], v1[1], v1[2], v1[3]}; float o[8];
#pragma unroll
                    for (int i = 0; i < 8; ++i) o[i] = (fq == 0) ? sigmoidf_(v[i]) : al[i] * softplusf_(v[i] + db[i]);
                    float* dst = (fq == 0 ? beta : g) + (size_t)row * 8;
                    *(f32x4*)dst = (f32x4){o[0], o[1], o[2], o[3]}; *(f32x4*)(dst + 4) = (f32x4){o[4], o[5], o[6], o[7]}; }
        }
    }
};
struct EpiResid {
    static constexpr bool PERM = false, AFTER_DRAIN = false;
    const float* resid; float* out; bf16* xb; float* ssq;
    __device__ __forceinline__ void operator()(const pg8::f32x4 (&acc)[2][2][4][2], const pg8::Unit& u, int wr, int wc, int fr, int fq) const {
        const int row0 = u.pm * 256 + wr * 64 + fr, col0 = u.pn * 256 + wc * 32 + 4 * fq;
#pragma unroll
        for (int ai = 0; ai < 2; ++ai)
#pragma unroll
            for (int m = 0; m < 4; ++m) { const int row = row0 + ai * 128 + m * 16; const size_t off = (size_t)row * D + col0; float ss = 0.f;
#pragma unroll
                for (int bj = 0; bj < 2; ++bj)
#pragma unroll
                    for (int n = 0; n < 2; ++n) { const size_t o2 = off + bj * 128 + n * 16; const f32x4 rs = *(const f32x4*)(resid + o2); const f32x4 hv = rs + acc[ai][bj][m][n];
                        *(f32x4*)(out + o2) = hv; u32x2 w; w.x = cvtpk(hv[0], hv[1]); w.y = cvtpk(hv[2], hv[3]); *(u32x2*)(xb + o2) = w;
                        ss += (hv[0] * hv[0] + hv[1] * hv[1]) + (hv[2] * hv[2] + hv[3] * hv[3]); }
                ss += __shfl_xor(ss, 16); ss += __shfl_xor(ss, 32);
                if (fq == 0) ssq[(size_t)row * 16 + u.pn * 4 + wc] = ss; }
    }
};
DI float rstd_from_ssq(const float* ssq, int row) {
    const f32x4 a = *(const f32x4*)(ssq + (size_t)row * 16), b = *(const f32x4*)(ssq + (size_t)row * 16 + 4), c = *(const f32x4*)(ssq + (size_t)row * 16 + 8), d = *(const f32x4*)(ssq + (size_t)row * 16 + 12);
    const float s = ((a[0] + a[1]) + (a[2] + a[3])) + ((b[0] + b[1]) + (b[2] + b[3])) + ((c[0] + c[1]) + (c[2] + c[3])) + ((d[0] + d[1]) + (d[2] + d[3]));
    return rsqrtf(s * (1.f / D) + RMS_EPS);
}
struct EpiUp {
    static constexpr bool PERM = true, AFTER_DRAIN = false;
    bf16* hid; const float* ssq;
    __device__ __forceinline__ void operator()(const pg8::f32x4 (&acc)[2][2][4][2], const pg8::Unit& u, int wr, int wc, int fr, int fq) const {
        const int row0 = u.pm * 256 + wr * 64 + fr, col0 = u.pn * 256 + wc * 32 + 8 * fq;
#pragma unroll
        for (int ai = 0; ai < 2; ++ai)
#pragma unroll
            for (int m = 0; m < 4; ++m) { const int row = row0 + ai * 128 + m * 16; const float rs = rstd_from_ssq(ssq, row); bf16* rowp = hid + (size_t)row * FF + col0;
#pragma unroll
                for (int bj = 0; bj < 2; ++bj) { pg8::f32x4 v0 = acc[ai][bj][m][0] * rs, v1 = acc[ai][bj][m][1] * rs;
#pragma unroll
                    for (int i = 0; i < 4; ++i) { const float a = fmaxf(v0[i], 0.f), b = fmaxf(v1[i], 0.f); v0[i] = a * a; v1[i] = b * b; }
                    v4u w; w.x = cvtpk(v0[0], v0[1]); w.y = cvtpk(v0[2], v0[3]); w.z = cvtpk(v1[0], v1[1]); w.w = cvtpk(v1[2], v1[3]);
                    *(v4u*)(rowp + bj * 128) = w; } }
    }
};
struct EpiMbIn {
    static constexpr bool PERM = true, AFTER_DRAIN = false;
    bf16 *QKV1; float* kpart; const float* ssq;
    __device__ __forceinline__ void operator()(const pg8::f32x4 (&acc)[2][2][4][2], const pg8::Unit& u, int wr, int wc, int fr, int fq) const {
        const int row0 = u.pm * 256 + wr * 64 + fr; const int ts = u.pn >> 2; bf16* base = QKV1 + (size_t)ts * M * D;
        const int col0 = (u.pn & 3) * 256 + wc * 32 + 8 * fq; const float sc = ts == 0 ? QSCALE : 1.f;
        float cs[2][8];
#pragma unroll
        for (int bj = 0; bj < 2; ++bj)
#pragma unroll
            for (int i = 0; i < 8; ++i) cs[bj][i] = 0.f;
#pragma unroll
        for (int ai = 0; ai < 2; ++ai)
#pragma unroll
            for (int m = 0; m < 4; ++m) { const int row = row0 + ai * 128 + m * 16; const float rs = rstd_from_ssq(ssq, row) * sc; bf16* rowp = base + (size_t)row * D + col0;
#pragma unroll
                for (int bj = 0; bj < 2; ++bj) { const pg8::f32x4 v0 = acc[ai][bj][m][0] * rs, v1 = acc[ai][bj][m][1] * rs;
#pragma unroll
                    for (int i = 0; i < 4; ++i) { cs[bj][i] += v0[i]; cs[bj][4 + i] += v1[i]; }
                    v4u w; w.x = cvtpk(v0[0], v0[1]); w.y = cvtpk(v0[2], v0[3]); w.z = cvtpk(v1[0], v1[1]); w.w = cvtpk(v1[2], v1[3]);
                    *(v4u*)(rowp + bj * 128) = w; } }
        if (ts == 1) {
#pragma unroll
            for (int bj = 0; bj < 2; ++bj)
#pragma unroll
                for (int i = 0; i < 8; ++i) { float s = cs[bj][i]; s += __shfl_xor(s, 1); s += __shfl_xor(s, 2); s += __shfl_xor(s, 4); s += __shfl_xor(s, 8); cs[bj][i] = s; }
            if (fr == 0) { float* dst = kpart + (size_t)(u.pm * 2 + wr) * D + col0;
#pragma unroll
                for (int bj = 0; bj < 2; ++bj) { *(f32x4*)(dst + bj * 128) = (f32x4){cs[bj][0], cs[bj][1], cs[bj][2], cs[bj][3]}; *(f32x4*)(dst + bj * 128 + 4) = (f32x4){cs[bj][4], cs[bj][5], cs[bj][6], cs[bj][7]}; } }
        }
    }
};

DI void p0_transpose_item(const float* W, int ldw, int K, const float* gk, bf16* WT, LAS float* scr, int item, int nblk, int lane) {
    const int kb = item / nblk, nb = item % nblk, k0 = 64 * kb, n0 = 32 * nb;
#pragma unroll 8
    for (int i = 0; i < 32; ++i) { const int kk = 2 * i + (lane >> 5); float w = W[(size_t)(k0 + kk) * ldw + n0 + (lane & 31)]; if (gk) w *= gk[k0 + kk]; scr[kk * 33 + (lane & 31)] = w; }
    LDS_WAIT(); asm volatile("" ::: "memory");
    const int c = lane & 7;
#pragma unroll
    for (int j = 0; j < 4; ++j) { const int n = (lane >> 3) + 8 * j; const LAS float* s = scr + (8 * c) * 33 + n;
        v4u o; o.x = cvtpk(s[0 * 33], s[1 * 33]); o.y = cvtpk(s[2 * 33], s[3 * 33]); o.z = cvtpk(s[4 * 33], s[5 * 33]); o.w = cvtpk(s[6 * 33], s[7 * 33]);
        *(GAS v4u*)(WT + (size_t)(n0 + n) * K + k0 + 8 * c) = o; }
    LDS_WAIT(); asm volatile("" ::: "memory");
}
DI void rms_row_to_bf16(const float* xrow, const float* gain, bf16* orow, int lane) {
    const GAS f32x4* xr = (const GAS f32x4*)xrow + lane; const GAS f32x4* gr = (const GAS f32x4*)gain + lane;
    f32x4 v[4]; float s = 0.f;
#pragma unroll
    for (int j = 0; j < 4; ++j) { v[j] = xr[64 * j]; s += (v[j].x * v[j].x + v[j].y * v[j].y) + (v[j].z * v[j].z + v[j].w * v[j].w); }
    const float rstd = rsqrtf(wave_sum(s) * (1.f / D) + RMS_EPS);
    GAS unsigned long long* o8 = (GAS unsigned long long*)orow + lane;
#pragma unroll
    for (int j = 0; j < 4; ++j) { const f32x4 gg = gr[64 * j]; o8[64 * j] = (unsigned long long)cvtpk(v[j].x * rstd * gg.x, v[j].y * rstd * gg.y) | ((unsigned long long)cvtpk(v[j].z * rstd * gg.z, v[j].w * rstd * gg.w) << 32); }
}
DI void p0_prologue(Frame& F) {
    LAS float* scr = (LAS float*)(F.lds + F.wave * 16384);
    const int gw = F.vcu * NWAVES + F.wave, NGW = F.G * NWAVES;
    bf16* const wdnin = (bf16*)(F.ws + WS_WDNIN);
    constexpr int I_DNIN = (D / 64) * (4096 / 32), I_SQ = (D / 64) * (D / 32), I_UP = (D / 64) * (FF / 32), I_DOWN = (FF / 64) * (D / 32), I_MBIN = (D / 64) * (NMB / 32);
    constexpr int NITEMS = I_DNIN + I_SQ + I_UP + I_DOWN + I_MBIN + I_SQ + I_UP + I_DOWN;
    for (int it = gw; it < NITEMS; it += NGW) {
        int r = it;
        if (r < I_DNIN) { p0_transpose_item(F.dn_w_in, NDN, D, nullptr, wdnin, scr, r, 4096 / 32, F.lane); continue; } r -= I_DNIN;
        if (r < I_SQ) { p0_transpose_item(F.dn_w_out, D, D, nullptr, (bf16*)(F.ws + WS_WDNOUT), scr, r, D / 32, F.lane); continue; } r -= I_SQ;
        if (r < I_UP) { p0_transpose_item(F.w_up, FF, D, F.mlp_g, (bf16*)(F.ws + WS_WUP0), scr, r, FF / 32, F.lane); continue; } r -= I_UP;
        if (r < I_DOWN) { p0_transpose_item(F.w_down, D, FF, nullptr, (bf16*)(F.ws + WS_WDOWN0), scr, r, D / 32, F.lane); continue; } r -= I_DOWN;
        if (r < I_MBIN) { p0_transpose_item(F.mb_w_in, NMB, D, F.mix_g + D, (bf16*)(F.ws + WS_WMBIN), scr, r, NMB / 32, F.lane); continue; } r -= I_MBIN;
        if (r < I_SQ) { p0_transpose_item(F.mb_w_out, D, D, nullptr, (bf16*)(F.ws + WS_WMBOUT), scr, r, D / 32, F.lane); continue; } r -= I_SQ;
        if (r < I_UP) { p0_transpose_item(F.w_up + (size_t)D * FF, FF, D, F.mlp_g + D, (bf16*)(F.ws + WS_WUP1), scr, r, FF / 32, F.lane); continue; } r -= I_UP;
        p0_transpose_item(F.w_down + (size_t)FF * D, D, FF, nullptr, (bf16*)(F.ws + WS_WDOWN1), scr, r, D / 32, F.lane);
    }
    const int gt = F.vcu * (NWAVES * 64) + F.tid, NGT = F.G * NWAVES * 64;
    for (int e = gt; e < 16 * D; e += NGT) { const int n = e >> 10, k = e & (D - 1); wdnin[(size_t)(4096 + n) * D + k] = (bf16)f2bf(F.dn_w_in[(size_t)k * NDN + 4096 + n]); }
    for (int e = gt; e < (NDN_PAD - NDN) * D / 8; e += NGT) ((GAS v4u*)(wdnin + (size_t)NDN * D))[e] = (v4u){0u, 0u, 0u, 0u};
    bf16* XN = (bf16*)(F.ws + WS_CH);
    for (int m = gw; m < M; m += NGW) rms_row_to_bf16(F.x + (size_t)m * D, F.mix_g, XN + (size_t)m * D, F.lane);
}

DI void p_final(Frame& F) {
    const int gw = F.vcu * NWAVES + F.wave, NGW = F.G * NWAVES; const float* ssq = (const float*)(F.ws + WS_SSQ + 3 * 2 * MiB);
    for (int m = gw; m < M; m += NGW) {
        const float rs = rstd_from_ssq(ssq, m);
        GAS f32x4* xr = (GAS f32x4*)(F.out + (size_t)m * D) + F.lane; const GAS f32x4* gr = (const GAS f32x4*)F.final_g + F.lane;
#pragma unroll
        for (int j = 0; j < 4; ++j) { f32x4 v = xr[64 * j]; const f32x4 gg = gr[64 * j]; v = v * rs; v = v * gg; xr[64 * j] = v; }
    }
}

namespace attn {
constexpr int KP = 136, VP = 72;
constexpr int LDS_K = 0, LDS_V = 2 * 64 * KP * 2, LDS_KM = LDS_V + 2 * 128 * VP * 2, LDS_END = LDS_KM + 32 * KP * 2;
DI void attn_unit(int b, int h, int qb, const bf16* Q, const bf16* K, const bf16* V, const float* kpart, bf16* O, LAS unsigned char* lds, int tid) {
    const int lane = tid & 63, wid = __builtin_amdgcn_readfirstlane(tid >> 6), r = lane & 31, hh = lane >> 5;
    const size_t rowbase = (size_t)b * T;
    LAS bf16* KM = (LAS bf16*)(lds + LDS_KM);
    for (int e = tid; e < 32 * 128; e += NWAVES * 64) { const int j = e >> 7, d = e & 127; float v = 0.f;
        if (j < qb) { const float* p = kpart + ((size_t)(b * 16 + j) * 2) * D + h * HD + d; v = (p[0] + p[D]) * (1.f / 256.f); }
        KM[j * KP + d] = (bf16)f2bf(v); }
    const bf16* qrow = Q + (rowbase + qb * 256 + wid * 32 + r) * D + h * HD + hh * 8;
    bf16x8 qf[8];
#pragma unroll
    for (int ks = 0; ks < 8; ++ks) qf[ks] = *(const bf16x8*)(qrow + ks * 16);
    __syncthreads();
    f32x16 gt;
#pragma unroll
    for (int i = 0; i < 16; ++i) gt[i] = 0.f;
#pragma unroll
    for (int ks = 0; ks < 8; ++ks) { const bf16x8 a = *(const LAS bf16x8*)(KM + r * KP + ks * 16 + hh * 8); gt = MFMA32(a, qf[ks], gt); }
    float sc[16];
#pragma unroll
    for (int i = 0; i < 8; ++i) { const float own = gt[i], oth = __shfl_xor(own, 32); const int blo = 8 * (i >> 2) + (i & 3);
        sc[blo] = hh ? oth : own; sc[blo + 4] = hh ? own : oth; }
    unsigned mask = 0u;
#pragma unroll
    for (int rep = 0; rep < 3; ++rep) { float best = -INFINITY; int bi = -1;
#pragma unroll
        for (int j = 0; j < 16; ++j) { const bool ok = (j < qb) && !((mask >> j) & 1u) && (sc[j] > best); best = ok ? sc[j] : best; bi = ok ? j : bi; }
        if (bi >= 0) mask |= 1u << bi; }
    const float slope2 = exp2f(-(float)(h + 1)) * LOG2E;
    const float tq_rel = (float)(wid * 32 + r);
    float mrun = -1e30f, lrun = 0.f; f32x16 o[4];
#pragma unroll
    for (int dt = 0; dt < 4; ++dt)
#pragma unroll
        for (int i = 0; i < 16; ++i) o[dt][i] = 0.f;
    const int ntile = 4 * (qb + 1);
    v4u kreg[2], vreg[2];
    const bf16* Kh = K + rowbase * D + h * HD; const bf16* Vh = V + rowbase * D + h * HD;
#define ATT_LOAD(kt_) do { _Pragma("unroll") for (int i_ = 0; i_ < 2; ++i_) { const int idx_ = tid + 512 * i_, key_ = idx_ >> 4, c_ = idx_ & 15; \
        kreg[i_] = *(const v4u*)(Kh + (size_t)((kt_) * 64 + key_) * D + 8 * c_); vreg[i_] = *(const v4u*)(Vh + (size_t)((kt_) * 64 + key_) * D + 8 * c_); } } while (0)
    ATT_LOAD(0);
    for (int kt = 0; kt < ntile; ++kt) {
        const int buf = kt & 1;
        LAS bf16* Ks = (LAS bf16*)(lds + LDS_K) + buf * 64 * KP; LAS bf16* Vt = (LAS bf16*)(lds + LDS_V) + buf * 128 * VP;
#pragma unroll
        for (int i = 0; i < 2; ++i) { const int idx = tid + 512 * i, key = idx >> 4, c = idx & 15;
            *(LAS v4u*)(Ks + key * KP + 8 * c) = kreg[i];
            const unsigned w0 = vreg[i].x, w1 = vreg[i].y, w2 = vreg[i].z, w3 = vreg[i].w;
            Vt[(8 * c + 0) * VP + key] = (bf16)(w0 & 0xffffu); Vt[(8 * c + 1) * VP + key] = (bf16)(w0 >> 16);
            Vt[(8 * c + 2) * VP + key] = (bf16)(w1 & 0xffffu); Vt[(8 * c + 3) * VP + key] = (bf16)(w1 >> 16);
            Vt[(8 * c + 4) * VP + key] = (bf16)(w2 & 0xffffu); Vt[(8 * c + 5) * VP + key] = (bf16)(w2 >> 16);
            Vt[(8 * c + 6) * VP + key] = (bf16)(w3 & 0xffffu); Vt[(8 * c + 7) * VP + key] = (bf16)(w3 >> 16); }
        __syncthreads();
        if (kt + 1 < ntile) ATT_LOAD(kt + 1);
        const int j = kt >> 2, tk0 = 64 * (kt & 3); const bool own = (j == qb); const bool sel = own || ((mask >> j) & 1u);
        if (__ballot(sel) == 0ull) continue;
        f32x16 p0, p1;
#pragma unroll
        for (int i = 0; i < 16; ++i) { p0[i] = 0.f; p1[i] = 0.f; }
#pragma unroll
        for (int ks = 0; ks < 8; ++ks) { const bf16x8 a0 = *(const LAS bf16x8*)(Ks + r * KP + ks * 16 + hh * 8), a1 = *(const LAS bf16x8*)(Ks + (32 + r) * KP + ks * 16 + hh * 8);
            p0 = MFMA32(a0, qf[ks], p0); p1 = MFMA32(a1, qf[ks], p1); }
        const float kb0 = (float)(tk0 + 4 * hh); const float base = slope2 * ((float)(256 * (j - qb)) + kb0 - tq_rel);
        float mx = -INFINITY;
#pragma unroll
        for (int i = 0; i < 16; ++i) { const float cr = (float)((i & 3) + 8 * (i >> 2));
            float s0 = p0[i] + (base + slope2 * cr), s1 = p1[i] + (base + slope2 * (cr + 32.f));
            if (own) { if (kb0 + cr > tq_rel) s0 = -INFINITY; if (kb0 + cr + 32.f > tq_rel) s1 = -INFINITY; }
            if (!sel) { s0 = -INFINITY; s1 = -INFINITY; }
            p0[i] = s0; p1[i] = s1; mx = fmaxf(mx, fmaxf(s0, s1)); }
        mx = fmaxf(mx, __shfl_xor(mx, 32));
        const float mnew = fmaxf(mrun, mx); const float alpha = exp2f(mrun - mnew); mrun = mnew;
        float rs = 0.f;
#pragma unroll
        for (int i = 0; i < 16; ++i) { p0[i] = exp2f(p0[i] - mnew); p1[i] = exp2f(p1[i] - mnew); rs += p0[i] + p1[i]; }
        rs += __shfl_xor(rs, 32);
        lrun = lrun * alpha + rs;
#pragma unroll
        for (int dt = 0; dt < 4; ++dt)
#pragma unroll
            for (int i = 0; i < 16; ++i) o[dt][i] *= alpha;
        bf16x8 pb[2][2];
#pragma unroll
        for (int s = 0; s < 2; ++s) {
            v4u w0, w1;
            w0.x = cvtpk(p0[8 * s + 0], p0[8 * s + 1]); w0.y = cvtpk(p0[8 * s + 2], p0[8 * s + 3]); w0.z = cvtpk(p0[8 * s + 4], p0[8 * s + 5]); w0.w = cvtpk(p0[8 * s + 6], p0[8 * s + 7]);
            w1.x = cvtpk(p1[8 * s + 0], p1[8 * s + 1]); w1.y = cvtpk(p1[8 * s + 2], p1[8 * s + 3]); w1.z = cvtpk(p1[8 * s + 4], p1[8 * s + 5]); w1.w = cvtpk(p1[8 * s + 6], p1[8 * s + 7]);
            pb[0][s] = __builtin_bit_cast(bf16x8, w0); pb[1][s] = __builtin_bit_cast(bf16x8, w1); }
#pragma unroll
        for (int dt = 0; dt < 4; ++dt)
#pragma unroll
            for (int kh = 0; kh < 2; ++kh)
#pragma unroll
                for (int s = 0; s < 2; ++s) { const LAS bf16* vp = Vt + (32 * dt + r) * VP + 32 * kh + 16 * s + 4 * hh;
                    const s16x4 lo = *(const LAS s16x4*)vp, hi = *(const LAS s16x4*)(vp + 8);
                    const bf16x8 a = __builtin_shufflevector(lo, hi, 0, 1, 2, 3, 4, 5, 6, 7);
                    o[dt] = MFMA32(a, pb[kh][s], o[dt]); }
    }
#undef ATT_LOAD
    const float inv = 1.f / lrun;
    bf16* orow = O + (rowbase + qb * 256 + wid * 32 + r) * D + h * HD + 4 * hh;
#pragma unroll
    for (int dt = 0; dt < 4; ++dt)
#pragma unroll
        for (int g = 0; g < 4; ++g) { u32x2 w; w.x = cvtpk(o[dt][4 * g] * inv, o[dt][4 * g + 1] * inv); w.y = cvtpk(o[dt][4 * g + 2] * inv, o[dt][4 * g + 3] * inv);
            *(u32x2*)(orow + 32 * dt + 8 * g) = w; }
    __syncthreads();
}
DI void attn_phase(Frame& F, const bf16* Q, const bf16* K, const bf16* V, const float* kpart, bf16* O) {
    for (int pu = F.vcu; pu < BATCH * H * 8; pu += F.G) { const int bh = pu >> 3, p = pu & 7;
        attn_unit(bh >> 3, bh & 7, 15 - p, Q, K, V, kpart, O, F.lds, F.tid);
        attn_unit(bh >> 3, bh & 7, p, Q, K, V, kpart, O, F.lds, F.tid); }
}
}

#ifndef USE_REF_DELTA
#define USE_REF_DELTA 0
#endif
#ifndef MK_ONE_LAUNCH
#define MK_ONE_LAUNCH 1
#endif
#if USE_REF_DELTA
__global__ void __launch_bounds__(512) ref_conv(const bf16* q0, const bf16* k0, const bf16* v0, const float* conv_w, bf16* outc) {
    const int m = blockIdx.x / 3, ts = blockIdx.x % 3, tid = threadIdx.x, t = m % T;
    const bf16* src = ts == 0 ? q0 : ts == 1 ? k0 : v0;
    float y[2];
#pragma unroll
    for (int e = 0; e < 2; ++e) { const int c = 2 * tid + e; float a = 0.f;
#pragma unroll
        for (int j = 0; j < 4; ++j) { const int tt = t - 3 + j; if (tt >= 0) a += conv_w[(size_t)j * 3 * D + ts * D + c] * bf2f(src[(size_t)(m - 3 + j) * D + c]); }
        y[e] = siluf_(a); }
    if (ts < 2) { const float ss = wave_sum(y[0] * y[0] + y[1] * y[1]); float rn = rsqrtf(ss + 1e-6f); if (ts == 0) rn *= 0.08838834764831845f; y[0] *= rn; y[1] *= rn; }
    *(unsigned*)(outc + (size_t)ts * M * D + (size_t)m * D + 2 * tid) = cvtpk(y[0], y[1]);
}
__global__ void __launch_bounds__(256) ref_delta(const bf16* qkvc, const bf16* z, const float* beta, const float* gl, const float* out_g, bf16* a0) {
    __shared__ float ks[128], qs[128], red[2][128], red2[2][128], wsum[2];
    const int b = blockIdx.x >> 3, h = blockIdx.x & 7, tid = threadIdx.x, dvi = tid & 127, half = tid >> 7;
    const bf16* qc = qkvc + h * HD; const bf16* kc = qkvc + (size_t)M * D + h * HD; const bf16* vc = qkvc + 2 * (size_t)M * D + h * HD;
    float S[64];
#pragma unroll
    for (int i = 0; i < 64; ++i) S[i] = 0.f;
    const float og = out_g[dvi];
    for (int t = 0; t < T; ++t) {
        const size_t m = (size_t)b * T + t;
        if (tid < 128) ks[tid] = bf2f(kc[m * D + tid]); else qs[tid - 128] = bf2f(qc[m * D + tid - 128]);
        const float v = bf2f(vc[m * D + dvi]); const float bt = beta[m * 8 + h], eg = __expf(gl[m * 8 + h]);
        __syncthreads();
        float part = 0.f;
#pragma unroll
        for (int i = 0; i < 64; ++i) { S[i] *= eg; part += ks[half * 64 + i] * S[i]; }
        red[half][dvi] = part;
        __syncthreads();
        const float delta = bt * (v - (red[0][dvi] + red[1][dvi]));
        float po = 0.f;
#pragma unroll
        for (int i = 0; i < 64; ++i) { S[i] += ks[half * 64 + i] * delta; po += qs[half * 64 + i] * S[i]; }
        red2[half][dvi] = po;
        __syncthreads();
        float o = 0.f;
        if (half == 0) { o = red2[0][dvi] + red2[1][dvi]; const float ss = wave_sum(o * o); if ((tid & 63) == 0) wsum[tid >> 6] = ss; }
        __syncthreads();
        if (half == 0) { const float rstd = rsqrtf((wsum[0] + wsum[1]) * (1.f / HD) + RMS_EPS); const float zz = bf2f(z[m * D + h * HD + dvi]);
            a0[m * D + h * HD + dvi] = (bf16)f2bf(o * rstd * og * siluf_(zz)); }
    }
}
DI void p2_chunks(Frame&) {}
DI void p3_scan(Frame&) {}
#endif

struct Args { const float* in[14]; float* out; unsigned char* ws; int ph_lo, ph_hi; };
static_assert(sizeof(Args) == 14 * 8 + 8 + 8 + 8, "Args has no padding");
constexpr int N_PHASES = 13;
__global__ void __launch_bounds__(NWAVES * 64, 2) fwd(Args args) {
    extern __shared__ __attribute__((aligned(16))) unsigned char lds_raw[];
    Frame F;
    F.lds = (LAS unsigned char*)lds_raw;
    F.MISC = (volatile LAS unsigned*)(F.lds + MISC_OFF);
    F.tid = threadIdx.x; F.lane = F.tid & 63; F.wave = __builtin_amdgcn_readfirstlane(F.tid >> 6);
    F.G = gridDim.x; { const int bx = blockIdx.x; F.vcu = (F.G % 8 == 0) ? (bx % 8) * (F.G / 8) + bx / 8 : bx; }
    F.ws = args.ws; F.ctl = (gu32*)(args.ws + WS_CTL); F.out = args.out;
    F.x = args.in[0]; F.mix_g = args.in[1]; F.mlp_g = args.in[2]; F.dn_w_in = args.in[3]; F.dn_conv_w = args.in[4]; F.dn_a_log = args.in[5]; F.dn_dt_bias = args.in[6];
    F.dn_out_g = args.in[7]; F.dn_w_out = args.in[8]; F.mb_w_in = args.in[9]; F.mb_w_out = args.in[10]; F.w_up = args.in[11]; F.w_down = args.in[12]; F.final_g = args.in[13];
    for (int u = F.tid; u < (LDS_BYTES - MISC_OFF) / 4; u += NWAVES * 64) ((LAS unsigned*)(F.lds + MISC_OFF))[u] = 0u;
    __syncthreads();
    const int lo = args.ph_lo, hi = args.ph_hi;
    const bool multi = (hi - lo) > 1;
    XcdBarrier bar; bar.bar = (unsigned*)(F.ctl + CW_BAR); bar.x = 0; bar.st = nullptr;
    if (multi) bar = xcd_barrier_post((unsigned*)(F.ctl + CW_BAR), F.MISC + 8);
#define IN(k) (lo <= (k) && (k) < hi)
#define SEAM(k) do { if (IN(k) && IN((k) + 1)) xcd_barrier(bar); } while (0)
    unsigned char* const ws = args.ws;
    bf16* const Q0 = (bf16*)(ws + WS_Q0); bf16* const XB = (bf16*)(ws + WS_K0); bf16* const CHB = (bf16*)(ws + WS_CH);
    bf16* const Zb = (bf16*)args.out; bf16* const V0 = (bf16*)((unsigned char*)args.out + 64 * MiB);
    float* const ssq = (float*)(ws + WS_SSQ); constexpr size_t SSQ_STRIDE = (size_t)M * 16;
    float* const kpart = (float*)(ws + WS_KPART);

    if (IN(0)) { p0_prologue(F); } SEAM(0);
    if (IN(1)) {
        pg8::Gemm g{CHB, (const bf16*)(ws + WS_WDNIN), M, NDN_PAD, D}; pg8::StaticOrder S; S.init(M, NDN_PAD, F.G, (int)blockIdx.x);
        EpiDnIn E{Q0, Zb, (float*)(ws + WS_BETA), (float*)(ws + WS_G), F.dn_a_log, F.dn_dt_bias};
        pg8::gemm_phase<EpiDnIn, pg8::StaticOrder, true, true>(F.lds, g, S, E);
    } SEAM(1);
    if (IN(2)) { p2_chunks(F); } SEAM(2);
    if (IN(3)) { p3_scan(F); } SEAM(3);
    if (IN(4)) {
        pg8::Gemm g{Q0, (const bf16*)(ws + WS_WDNOUT), M, D, D}; pg8::StaticOrder S; S.init(M, D, F.G, (int)blockIdx.x);
        EpiResid E{F.x, F.out, XB, ssq + 0 * SSQ_STRIDE};
        pg8::gemm_phase<EpiResid, pg8::StaticOrder, true, true>(F.lds, g, S, E);
    } SEAM(4);
    if (IN(5)) {
        pg8::Gemm g{XB, (const bf16*)(ws + WS_WUP0), M, FF, D}; pg8::StaticOrder S; S.init(M, FF, F.G, (int)blockIdx.x);
        EpiUp E{CHB, ssq + 0 * SSQ_STRIDE};
        pg8::gemm_phase<EpiUp, pg8::StaticOrder, true, true>(F.lds, g, S, E);
    } SEAM(5);
    if (IN(6)) {
        pg8::Gemm g{CHB, (const bf16*)(ws + WS_WDOWN0), M, D, FF}; pg8::StaticOrder S; S.init(M, D, F.G, (int)blockIdx.x);
        EpiResid E{F.out, F.out, XB, ssq + 1 * SSQ_STRIDE};
        pg8::gemm_phase<EpiResid, pg8::StaticOrder, true, true>(F.lds, g, S, E);
    } SEAM(6);
    bf16* const Q1 = CHB; bf16* const K1 = (bf16*)(ws + WS_CH + 64 * MiB); bf16* const V1 = (bf16*)(ws + WS_CH + 128 * MiB);
    if (IN(7)) {
        pg8::Gemm g{XB, (const bf16*)(ws + WS_WMBIN), M, NMB, D}; pg8::StaticOrder S; S.init(M, NMB, F.G, (int)blockIdx.x);
        EpiMbIn E{Q1, kpart, ssq + 1 * SSQ_STRIDE};
        pg8::gemm_phase<EpiMbIn, pg8::StaticOrder, true, true>(F.lds, g, S, E);
    } SEAM(7);
    if (IN(8)) { attn::attn_phase(F, Q1, K1, V1, kpart, Q0); } SEAM(8);
    if (IN(9)) {
        pg8::Gemm g{Q0, (const bf16*)(ws + WS_WMBOUT), M, D, D}; pg8::StaticOrder S; S.init(M, D, F.G, (int)blockIdx.x);
        EpiResid E{F.out, F.out, XB, ssq + 2 * SSQ_STRIDE};
        pg8::gemm_phase<EpiResid, pg8::StaticOrder, true, true>(F.lds, g, S, E);
    } SEAM(9);
    if (IN(10)) {
        pg8::Gemm g{XB, (const bf16*)(ws + WS_WUP1), M, FF, D}; pg8::StaticOrder S; S.init(M, FF, F.G, (int)blockIdx.x);
        EpiUp E{CHB, ssq + 2 * SSQ_STRIDE};
        pg8::gemm_phase<EpiUp, pg8::StaticOrder, true, true>(F.lds, g, S, E);
    } SEAM(10);
    if (IN(11)) {
        pg8::Gemm g{CHB, (const bf16*)(ws + WS_WDOWN1), M, D, FF}; pg8::StaticOrder S; S.init(M, D, F.G, (int)blockIdx.x);
        EpiResid E{F.out, F.out, XB, ssq + 3 * SSQ_STRIDE};
        pg8::gemm_phase<EpiResid, pg8::StaticOrder, true, true>(F.lds, g, S, E);
    } SEAM(11);
    if (IN(12)) { p_final(F); }
#undef IN
#undef SEAM
}

extern "C" void kernel_launch(void* const* d_in, const int* in_sizes, int n_in, void* d_out, int out_size, void* d_ws, size_t ws_size, hipStream_t stream) {
    static int grid = 0;
    if (grid == 0) {
        if (n_in != 14 || in_sizes[0] != M * D || out_size != M * D || ws_size < WS_END) { fprintf(stderr, "kernel_launch: unexpected shapes (n_in %d, in0 %d, out %d, ws %zu)\n", n_in, n_in > 0 ? in_sizes[0] : -1, out_size, ws_size); grid = -1; return; }
        int dev = 0, cus = 0, per_cu = 0;
        if (hipGetDevice(&dev) != hipSuccess || hipDeviceGetAttribute(&cus, hipDeviceAttributeMultiprocessorCount, dev) != hipSuccess) { grid = -1; return; }
        if (hipFuncSetAttribute((const void*)fwd, hipFuncAttributeMaxDynamicSharedMemorySize, LDS_BYTES) != hipSuccess) { fprintf(stderr, "kernel_launch: hipFuncSetAttribute failed\n"); grid = -1; return; }
        if (hipOccupancyMaxActiveBlocksPerMultiprocessor(&per_cu, (const void*)fwd, NWAVES * 64, LDS_BYTES) != hipSuccess || per_cu < 1) fprintf(stderr, "kernel_launch: occupancy query says %d\n", per_cu);
        (void)hipGetLastError();
        grid = cus;
    }
    if (grid < 0) return;
    (void)hipMemsetAsync((char*)d_ws + WS_CTL, 0, CTL_ZERO_BYTES, stream);
    Args a{};
    for (int i = 0; i < 14; ++i) a.in[i] = (const float*)d_in[i];
    a.out = (float*)d_out; a.ws = (unsigned char*)d_ws;
#if MK_ONE_LAUNCH
    a.ph_lo = 0; a.ph_hi = N_PHASES;
    hipLaunchKernelGGL(fwd, dim3(grid), dim3(NWAVES * 64), LDS_BYTES, stream, a);
#else
    for (int ph = 0; ph < N_PHASES; ++ph) {
#if USE_REF_DELTA
        if (ph == 2) { hipLaunchKernelGGL(ref_conv, dim3(M * 3), dim3(512), 0, stream, (const bf16*)((char*)d_ws + WS_Q0), (const bf16*)((char*)d_ws + WS_K0), (const bf16*)((char*)d_out + 64 * MiB),
                                          (const float*)d_in[4], (bf16*)((char*)d_ws + WS_CH)); continue; }
        if (ph == 3) { hipLaunchKernelGGL(ref_delta, dim3(BATCH * H), dim3(256), 0, stream, (const bf16*)((char*)d_ws + WS_CH), (const bf16*)d_out, (const float*)((char*)d_ws + WS_BETA), (const float*)((char*)d_ws + WS_G),
                                          (const float*)d_in[7], (bf16*)((char*)d_ws + WS_Q0)); continue; }
#endif
        a.ph_lo = ph; a.ph_hi = ph + 1;
        hipLaunchKernelGGL(fwd, dim3(grid), dim3(NWAVES * 64), LDS_BYTES, stream, a);
    }
#endif
}
```

```cpp
#include <hip/hip_runtime.h>
#include <cstdio>
#include <cstdint>
#include <cmath>
#define USE_REF_DELTA 0
#define MK_ONE_LAUNCH 1
namespace pg8 {
#define PG8_LAS __attribute__((address_space(3)))
typedef unsigned short bf16_t;
typedef short bf16x8 __attribute__((ext_vector_type(8)));
typedef float f32x4 __attribute__((ext_vector_type(4)));
typedef unsigned u32x4 __attribute__((ext_vector_type(4)));
constexpr int BM = 256, BK = 64, HALF = 128, HTB = HALF * BK * 2  , STAGE_BYTES = 8 * HTB, NXCD = 8, WGM = 4;

__host__ __device__ __forceinline__ int lds_byte(int r, int c) { const int st = (r >> 4) * 2 + (c >> 5), rr = r & 15, cc = c & 31, ob = rr * 64 + cc * 2; return st * 1024 + (ob ^ (((ob >> 9) & 1) << 5)); }
__host__ __device__ __forceinline__ void stage_rc(int b, int& R, int& C) { const int st = b / 1024, sb = b % 1024, swz = sb ^ (((sb >> 9) & 1) << 5); R = (st >> 1) * 16 + swz / 64; C = (st & 1) * 32 + (swz % 64) / 2; }
__host__ __device__ __forceinline__ int perm32(int rho) { const int n = rho >> 4, i = rho & 15; return 8 * (i >> 2) + 4 * n + (i & 3); }

struct Unit { int pm, pn, ui; };
struct Gemm { const bf16_t* A; const bf16_t* Bt; int M, N, K; };

struct StaticOrder {
    int nM, nN, nwg, G, c;
    __host__ __device__ void init(int M, int N, int G_, int c_) { nM = M / BM; nN = N / BM; nwg = nM * nN; G = G_; c = c_; }
    __host__ __device__ bool next(int i, Unit& u) const {
        const long L = (long)i * G + c; if (L >= nwg) return false;
        int wgid = (int)L; { const int q = nwg / NXCD, r = nwg % NXCD, xcd = wgid % NXCD, off = wgid / NXCD; wgid = (xcd < r ? xcd * (q + 1) : r * (q + 1) + (xcd - r) * q) + off; }
        const int nig = WGM * nN, gid = wgid / nig, fm = gid * WGM, gsz = (nM - fm) < WGM ? (nM - fm) : WGM;
        u.pm = fm + ((wgid % nig) % gsz); u.pn = (wgid % nig) / gsz; u.ui = i; return true;
    }
    __device__ __forceinline__ void a_ready(const Unit&) const {}
    __device__ __forceinline__ void done(const Unit&) const {}
};

__device__ __forceinline__ unsigned cvt_pk_bf16(float lo, float hi) { unsigned r; asm volatile("v_cvt_pk_bf16_f32 %0, %1, %2" : "=v"(r) : "v"(lo), "v"(hi)); return r; }
typedef float f32x2 __attribute__((ext_vector_type(2)));
template <class Epi, class Sched, bool ALIGN_EPI = false, bool SP2 = false>
__device__ __forceinline__ void gemm_phase(PG8_LAS unsigned char* lds, const Gemm g, const Sched& S, const Epi& E) {
    const int tid = threadIdx.x, wid = __builtin_amdgcn_readfirstlane(tid >> 6), lane = tid & 63, wr = wid >> 2, wc = wid & 3, fr = lane & 15, fq = lane >> 4;
    const int K = g.K, nt = K / BK;
    unsigned voffA[2], voffB[2];
#pragma unroll
    for (int i = 0; i < 2; ++i) { int R, C; stage_rc(tid * 16 + i * 8192, R, C); const int Rb = Epi::PERM ? ((R & ~31) + perm32(R & 31)) : R;
        voffA[i] = (unsigned)(R * K + C) * 2u; voffB[i] = (unsigned)(Rb * K + C) * 2u; }
    const size_t kstep = (size_t)(BK * 2);
    const size_t hstep = (size_t)HALF * K * 2;
    const size_t tstep = 2 * hstep;
    const unsigned ldsw = (unsigned)wid * 1024u;
    const int aoff = lds_byte(wr * 64 + fr, fq * 8), boff = lds_byte(wc * 32 + fr, fq * 8);
#define PG8_SA(b, h) (((b) * 2 + (h)) * HTB)
#define PG8_SB(b, h) ((4 + (b) * 2 + (h)) * HTB)
#define PG8_STAGE(bufoff, gbase, voff) do { _Pragma("unroll") for (int _i = 0; _i < 2; ++_i) \
        __builtin_amdgcn_global_load_lds((const unsigned*)((const char*)(gbase) + (voff)[_i]), (PG8_LAS unsigned*)(lds + (bufoff) + ldsw + _i * 8192), 16, 0, 0); } while (0)
#define PG8_LDA(dst, b, h) do { _Pragma("unroll") for (int m = 0; m < 4; ++m) _Pragma("unroll") for (int k = 0; k < 2; ++k) dst[m][k] = *(const PG8_LAS bf16x8*)(lds + PG8_SA(b, h) + aoff + m * 2048 + k * 1024); } while (0)
#define PG8_LDB(dst, b, h) do { _Pragma("unroll") for (int n = 0; n < 2; ++n) _Pragma("unroll") for (int k = 0; k < 2; ++k) dst[n][k] = *(const PG8_LAS bf16x8*)(lds + PG8_SB(b, h) + boff + n * 2048 + k * 1024); } while (0)
#define PG8_MMA(ai, bj, At, Bt) do { __builtin_amdgcn_s_setprio(1); _Pragma("unroll") for (int m = 0; m < 4; ++m) _Pragma("unroll") for (int n = 0; n < 2; ++n) _Pragma("unroll") for (int k = 0; k < 2; ++k) \
        acc[ai][bj][m][n] = __builtin_amdgcn_mfma_f32_16x16x32_bf16(Bt[n][k], At[m][k], acc[ai][bj][m][n], 0, 0, 0); __builtin_amdgcn_s_setprio(0); } while (0)
#define PG8_WAIT_V(n) asm volatile("s_waitcnt vmcnt(" #n ")" ::: "memory")
#define PG8_WAIT_L(n) asm volatile("s_waitcnt lgkmcnt(" #n ")" ::: "memory")
#define PG8_BAR __builtin_amdgcn_s_barrier()
#define PG8_SCHED __builtin_amdgcn_sched_barrier(0)
    Unit cur, nxt; int ui = 0;
    if (!S.next(0, cur)) return;
    f32x4 acc[2][2][4][2];
#pragma unroll
    for (int a = 0; a < 2; ++a)
#pragma unroll
        for (int b = 0; b < 2; ++b)
#pragma unroll
            for (int m = 0; m < 4; ++m)
#pragma unroll
                for (int n = 0; n < 2; ++n) acc[a][b][m][n] = (f32x4){0.f, 0.f, 0.f, 0.f};
    bf16x8 At[4][2], B0[2][2], B1[2][2];
    const char* cA = (const char*)g.A + (size_t)cur.pm * tstep; const char* cB = (const char*)g.Bt + (size_t)cur.pn * tstep;
    S.a_ready(cur);
    if constexpr (SP2) {
        PG8_STAGE(PG8_SB(0, 0), cB, voffB); PG8_STAGE(PG8_SB(0, 1), cB + hstep, voffB); PG8_STAGE(PG8_SA(0, 0), cA, voffA); PG8_STAGE(PG8_SA(0, 1), cA + hstep, voffA);
        if (wr == 1) PG8_BAR;
        PG8_WAIT_V(2); PG8_BAR;
        PG8_STAGE(PG8_SB(1, 0), cB + kstep, voffB); PG8_STAGE(PG8_SA(1, 0), cA + kstep, voffA); PG8_STAGE(PG8_SB(1, 1), cB + hstep + kstep, voffB);
        PG8_WAIT_V(6); PG8_BAR;
    } else {
        PG8_STAGE(PG8_SB(0, 0), cB, voffB); PG8_STAGE(PG8_SA(0, 0), cA, voffA); PG8_STAGE(PG8_SB(0, 1), cB + hstep, voffB); PG8_STAGE(PG8_SA(0, 1), cA + hstep, voffA);
        if (wr == 1) PG8_BAR;
        PG8_WAIT_V(4); PG8_BAR;
        PG8_STAGE(PG8_SB(1, 0), cB + kstep, voffB); PG8_STAGE(PG8_SA(1, 0), cA + kstep, voffA); PG8_STAGE(PG8_SB(1, 1), cB + hstep + kstep, voffB);
        PG8_WAIT_V(6); PG8_BAR;
    }
    for (;;) {
        const bool has_next = S.next(ui + 1, nxt);
        const char* nA = has_next ? (const char*)g.A + (size_t)nxt.pm * tstep : cA; const char* nB = has_next ? (const char*)g.Bt + (size_t)nxt.pn * tstep : cB;
        for (int t = 0; t < nt; t += 2) {
            const bool last = (t == nt - 2);
            const char* a1 = cA + (size_t)(t + 1) * kstep;
            const char* a2 = last ? nA : cA + (size_t)(t + 2) * kstep; const char* b2 = last ? nB : cB + (size_t)(t + 2) * kstep;
            const char* a3 = a2 + kstep; const char* b3 = b2 + kstep;
            if (last && has_next) S.a_ready(nxt);
            if constexpr (SP2) {
            PG8_LDB(B0, 0, 0); PG8_LDB(B1, 0, 1); PG8_SCHED; PG8_LDA(At, 0, 0); PG8_STAGE(PG8_SA(1, 1), a1 + hstep, voffA);
            PG8_WAIT_V(8); PG8_WAIT_L(0); PG8_BAR; PG8_MMA(0, 0, At, B0); PG8_MMA(0, 1, At, B1); PG8_BAR; PG8_SCHED;
            PG8_LDA(At, 0, 1); PG8_STAGE(PG8_SB(0, 0), b2, voffB); PG8_STAGE(PG8_SB(0, 1), b2 + hstep, voffB); PG8_STAGE(PG8_SA(0, 0), a2, voffA);
            PG8_WAIT_V(8); PG8_WAIT_L(0); PG8_BAR; PG8_MMA(1, 0, At, B0); PG8_MMA(1, 1, At, B1); PG8_BAR; PG8_SCHED;
            PG8_LDB(B0, 1, 0); PG8_LDB(B1, 1, 1); PG8_SCHED; PG8_LDA(At, 1, 0); PG8_STAGE(PG8_SA(0, 1), a2 + hstep, voffA);
            PG8_WAIT_V(8); PG8_WAIT_L(0); PG8_BAR; PG8_MMA(0, 0, At, B0); PG8_MMA(0, 1, At, B1); PG8_BAR; PG8_SCHED;
            PG8_LDA(At, 1, 1); PG8_STAGE(PG8_SB(1, 0), b3, voffB); PG8_STAGE(PG8_SB(1, 1), b3 + hstep, voffB); PG8_STAGE(PG8_SA(1, 0), a3, voffA);
            PG8_WAIT_V(8); PG8_WAIT_L(0); PG8_BAR; PG8_MMA(1, 0, At, B0); PG8_MMA(1, 1, At, B1); PG8_BAR; PG8_SCHED;
            } else {
            PG8_LDB(B0, 0, 0); PG8_SCHED; PG8_LDA(At, 0, 0); PG8_STAGE(PG8_SA(1, 1), a1 + hstep, voffA);
            PG8_WAIT_L(8); PG8_BAR; PG8_WAIT_L(0); PG8_MMA(0, 0, At, B0); PG8_BAR; PG8_SCHED;
            PG8_LDB(B1, 0, 1); PG8_STAGE(PG8_SB(0, 0), b2, voffB);
            PG8_BAR; PG8_WAIT_L(0); PG8_MMA(0, 1, At, B1); PG8_BAR;
            PG8_LDA(At, 0, 1); PG8_STAGE(PG8_SA(0, 0), a2, voffA);
            PG8_BAR; PG8_WAIT_L(0); PG8_MMA(1, 0, At, B0); PG8_BAR; PG8_SCHED;
            PG8_STAGE(PG8_SB(0, 1), b2 + hstep, voffB);
            PG8_WAIT_V(6); PG8_BAR; PG8_MMA(1, 1, At, B1); PG8_BAR;
            PG8_LDB(B0, 1, 0); PG8_SCHED; PG8_LDA(At, 1, 0); PG8_STAGE(PG8_SA(0, 1), a2 + hstep, voffA);
            PG8_WAIT_L(8); PG8_BAR; PG8_WAIT_L(0); PG8_MMA(0, 0, At, B0); PG8_BAR; PG8_SCHED;
            PG8_LDB(B1, 1, 1); PG8_STAGE(PG8_SB(1, 0), b3, voffB);
            PG8_BAR; PG8_WAIT_L(0); PG8_MMA(0, 1, At, B1); PG8_BAR;
            PG8_LDA(At, 1, 1); PG8_STAGE(PG8_SA(1, 0), a3, voffA);
            PG8_BAR; PG8_WAIT_L(0); PG8_MMA(1, 0, At, B0); PG8_BAR; PG8_SCHED;
            PG8_STAGE(PG8_SB(1, 1), b3 + hstep, voffB);
            PG8_WAIT_V(6); PG8_BAR; PG8_MMA(1, 1, At, B1); PG8_BAR;
            }
        }
        if constexpr (ALIGN_EPI) { if (wr == 0) PG8_BAR; }
        if constexpr (!Epi::AFTER_DRAIN) { E(acc, cur, wr, wc, fr, fq); S.done(cur); }
        if (!has_next) break;
#pragma unroll
        for (int a = 0; a < 2; ++a)
#pragma unroll
            for (int b = 0; b < 2; ++b)
#pragma unroll
                for (int m = 0; m < 4; ++m)
#pragma unroll
                    for (int n = 0; n < 2; ++n) acc[a][b][m][n] = (f32x4){0.f, 0.f, 0.f, 0.f};
        cur = nxt; cA = nA; cB = nB; ++ui;
        if constexpr (ALIGN_EPI) { if (wr == 1) PG8_BAR; }
    }
    PG8_WAIT_V(0);
    if constexpr (!ALIGN_EPI) { if (wr == 0) PG8_BAR; }
    PG8_BAR;
    if constexpr (Epi::AFTER_DRAIN) { E.fused(acc, cur, wr, wc, fr, fq, lds, wid, lane); S.done(cur); }
#undef PG8_SA
#undef PG8_SB
#undef PG8_STAGE
#undef PG8_LDA
#undef PG8_LDB
#undef PG8_MMA
#undef PG8_WAIT_V
#undef PG8_WAIT_L
#undef PG8_BAR
#undef PG8_SCHED
}
}
#define GAS __attribute__((address_space(1)))
#define LAS __attribute__((address_space(3)))
typedef unsigned short bf16;
typedef unsigned v4u __attribute__((ext_vector_type(4)));
typedef float f32x4 __attribute__((ext_vector_type(4)));
typedef short bf16x8 __attribute__((ext_vector_type(8)));
typedef GAS unsigned gu32;
typedef GAS unsigned long long gu64;
#define RLX_AGENT __ATOMIC_RELAXED, __HIP_MEMORY_SCOPE_AGENT
#define LDS_WAIT() asm volatile("s_waitcnt lgkmcnt(0)" ::: "memory")
#define VM_WAIT() asm volatile("s_waitcnt vmcnt(0)" ::: "memory")
__device__ __forceinline__ unsigned long long rt() { return __builtin_amdgcn_s_memrealtime(); }
__device__ __forceinline__ unsigned f2bf(float f) { unsigned u = __builtin_bit_cast(unsigned, f); return (u + 0x7fffu + ((u >> 16) & 1u)) >> 16; }
__device__ __forceinline__ unsigned pk2(float lo, float hi) { return f2bf(lo) | (f2bf(hi) << 16); }

#define XB_TMO      128
#define XB_XCNT(j)  (256  + 64 * (j))
#define XB_XSUB(j)  (1280 + 64 * (j))
#define XB_XGEN(j)  (2304 + 64 * (j))
#define XB_TOP      3328
#define XB_TOPGEN   3392
#define XCD_BAR_WORDS 3456
#define XB_SPIN_CAP (1u << 18)

__device__ __forceinline__ unsigned xb_ld(unsigned* p)              { return __hip_atomic_load(p, __ATOMIC_RELAXED, __HIP_MEMORY_SCOPE_AGENT); }
__device__ __forceinline__ unsigned xb_add(unsigned* p, unsigned v) { return __hip_atomic_fetch_add(p, v, __ATOMIC_RELAXED, __HIP_MEMORY_SCOPE_AGENT); }
__device__ __forceinline__ unsigned xb_xcc_id() { return (unsigned)__builtin_amdgcn_s_getreg((3 << 11) | 20) & 0xFu; }
#define XB_SPIN(cond, bar) do { unsigned _sp = 0; while (cond) { __builtin_amdgcn_s_sleep(1); \
    if ((++_sp & 255u) == 0u) { if (xb_ld(&(bar)[XB_TMO])) break; if (_sp > XB_SPIN_CAP) { atomicAdd(&(bar)[XB_TMO], 1u); break; } } } } while (0)

struct XcdBarrier {
    unsigned* bar; unsigned x;
    volatile LAS unsigned* st;
};

__device__ __forceinline__ XcdBarrier xcd_barrier_post(unsigned* bar, volatile LAS unsigned* st) {
    XcdBarrier b; b.bar = bar; b.x = xb_xcc_id(); b.st = st;
    if (threadIdx.x == 0) (void)xb_add(&bar[XB_XCNT(b.x)], 1u);
    return b;
}
__device__ __forceinline__ void xcd_barrier_complete(unsigned* bar, unsigned x, unsigned& nloc, unsigned& nx) {
    const unsigned G = gridDim.x * gridDim.y * gridDim.z;
    unsigned sum, cnt, mine, sp = 0u;
    for (;;) {
        sum = 0u; cnt = 0u; mine = 0u;
#pragma unroll
        for (unsigned j = 0; j < 16; ++j) { const unsigned c = xb_ld(&bar[XB_XCNT(j)]); sum += c; cnt += (c > 0u) ? 1u : 0u; mine = (j == x) ? c : mine; }
        if (sum == G) break;
        __builtin_amdgcn_s_sleep(1);
        if ((++sp & 255u) == 0u) { if (xb_ld(&bar[XB_TMO])) break; if (sp > XB_SPIN_CAP) { atomicAdd(&bar[XB_TMO], 1u); break; } }
    }
    nloc = mine > 0u ? mine : 1u; nx = cnt > 0u ? cnt : 1u;
}

__device__ __forceinline__ void xcd_barrier(const XcdBarrier& b) {
    asm volatile("s_waitcnt vmcnt(0)" ::: "memory");
    __syncthreads();
    if (threadIdx.x == 0) {
        unsigned* bar = b.bar;
        __builtin_amdgcn_s_waitcnt(0);
        unsigned nloc = b.st[0], nx = b.st[1];
        if (nloc == 0u) { xcd_barrier_complete(bar, b.x, nloc, nx); b.st[0] = nloc; b.st[1] = nx; }
        const unsigned old = xb_add(&bar[XB_XSUB(b.x)], 1u);
        const unsigned gen = old / nloc;
        if (old + 1u == (gen + 1u) * nloc) {
            __builtin_amdgcn_fence(__ATOMIC_RELEASE, "agent");
            asm volatile("s_waitcnt vmcnt(0)" ::: "memory");
            const unsigned og = xb_add(&bar[XB_TOP], 1u);
            const unsigned tg = og / nx;
            if (og + 1u == (tg + 1u) * nx) xb_add(&bar[XB_TOPGEN], 1u);
            else XB_SPIN(xb_ld(&bar[XB_TOPGEN]) == tg, bar);
            __builtin_amdgcn_fence(__ATOMIC_ACQUIRE, "agent");
            xb_add(&bar[XB_XGEN(b.x)], 1u);
            asm volatile("s_waitcnt vmcnt(0)" ::: "memory");
        } else {
            XB_SPIN(xb_ld(&bar[XB_XGEN(b.x)]) == gen, bar);
            __builtin_amdgcn_fence(__ATOMIC_ACQUIRE, "agent");
            asm volatile("s_waitcnt vmcnt(0)" ::: "memory");
        }
    }
    __syncthreads();
}

#define DI __device__ __forceinline__
typedef float f32x16 __attribute__((ext_vector_type(16)));
typedef short s16x4 __attribute__((ext_vector_type(4)));
typedef unsigned u32x2 __attribute__((ext_vector_type(2)));
typedef float f32x2_t __attribute__((ext_vector_type(2)));
typedef __bf16 bf16x2_t __attribute__((ext_vector_type(2)));
#define MFMA32(a, b, c) __builtin_amdgcn_mfma_f32_32x32x16_bf16((a), (b), (c), 0, 0, 0)
#define MFMA16(a, b, c) __builtin_amdgcn_mfma_f32_16x16x32_bf16((a), (b), (c), 0, 0, 0)

constexpr int BATCH = 8, T = 4096, D = 1024, H = 8, HD = 128, FF = 4096;
constexpr int M = BATCH * T;
constexpr int NDN = 4 * D + 2 * H;
constexpr int NDN_PAD = 4352;
constexpr int NMB = 3 * D;
constexpr int CL = 64, NCH = T / CL;
constexpr float RMS_EPS = 1e-6f;
constexpr int NWAVES = 8;
constexpr float LOG2E = 1.4426950408889634f;
constexpr float QSCALE = 0.08838834764831845f * LOG2E;

constexpr size_t MiB = 1u << 20;
constexpr size_t WS_CTL = 0, CTL_ZERO_BYTES = 1 * MiB;
constexpr size_t WS_BETA = 1 * MiB, WS_G = 2 * MiB, WS_KPART = 3 * MiB;
constexpr size_t WS_SSQ = 4 * MiB;
constexpr size_t WS_GTOT = 12 * MiB;
constexpr size_t WS_W = 13 * MiB;
constexpr size_t WS_WDNIN = WS_W, WS_WDNOUT = WS_WDNIN + (size_t)NDN_PAD * D * 2, WS_WUP0 = WS_WDNOUT + (size_t)D * D * 2, WS_WDOWN0 = WS_WUP0 + (size_t)FF * D * 2,
                 WS_WMBIN = WS_WDOWN0 + (size_t)FF * D * 2, WS_WMBOUT = WS_WMBIN + (size_t)NMB * D * 2, WS_WUP1 = WS_WMBOUT + (size_t)D * D * 2, WS_WDOWN1 = WS_WUP1 + (size_t)FF * D * 2,
                 WS_WEND = WS_WDOWN1 + (size_t)FF * D * 2;
static_assert(WS_WEND <= 64 * MiB, "weights fit below 64 MiB");
constexpr size_t WS_Q0 = 64 * MiB;
constexpr size_t WS_K0 = 128 * MiB;
constexpr size_t WS_CH = 192 * MiB;
constexpr size_t WS_END = 480 * MiB;
constexpr size_t CH_BYTES = 73728;
constexpr size_t CH_W = 0, CH_U = 16384, CH_QD = 32768, CH_KD = 49152, CH_AT = 65536;
static_assert(WS_CH + (size_t)BATCH * H * NCH * CH_BYTES <= WS_END, "chunk operand region");

constexpr int CW_TMO = 0, CW_CODE = 1, CW_ATTQ = 64, CW_BAR = 4096;

constexpr int LDS_BYTES = 163840;
constexpr int MISC_OFF = LDS_BYTES - 512;

#define LBAR() do { asm volatile("s_waitcnt lgkmcnt(0)" ::: "memory"); __builtin_amdgcn_s_barrier(); asm volatile("" ::: "memory"); } while (0)
DI float bf2f(unsigned short b) { return __uint_as_float((unsigned)b << 16); }
DI unsigned cvtpk(float lo, float hi) { f32x2_t v = {lo, hi}; bf16x2_t b = __builtin_convertvector(v, bf16x2_t); return __builtin_bit_cast(unsigned, b); }
DI float wave_sum(float v) {
#pragma unroll
    for (int o = 1; o < 64; o <<= 1) v += __shfl_xor(v, o);
    return v;
}
DI float xor1_f(float x) { return __int_as_float(__builtin_amdgcn_update_dpp(0, __float_as_int(x), 0xB1, 0xF, 0xF, true)); }
DI float xor2_f(float x) { return __int_as_float(__builtin_amdgcn_update_dpp(0, __float_as_int(x), 0x4E, 0xF, 0xF, true)); }
DI float ror4_f(float x) { return __int_as_float(__builtin_amdgcn_update_dpp(0, __float_as_int(x), 0x124, 0xF, 0xF, true)); }
DI float ror8_f(float x) { return __int_as_float(__builtin_amdgcn_update_dpp(0, __float_as_int(x), 0x128, 0xF, 0xF, true)); }
DI float sum16(float x) { x += xor1_f(x); x += xor2_f(x); x += ror4_f(x); x += ror8_f(x); return x; }
DI float sigmoidf_(float x) { return __builtin_amdgcn_rcpf(1.f + __builtin_amdgcn_exp2f(-LOG2E * x)); }
DI float siluf_(float x) { return x * __builtin_amdgcn_rcpf(1.f + __builtin_amdgcn_exp2f(-LOG2E * x)); }
DI unsigned short f2bfq(float x) { return (unsigned short)cvtpk(x, 0.f); }
DI float softplusf_(float x) { return fmaxf(x, 0.f) + log1pf(__expf(-fabsf(x))); }

struct Frame {
    LAS unsigned char* lds;
    volatile LAS unsigned* MISC;
    gu32* ctl;
    int tid, lane, wave;
    int vcu, G, var;
    const float *x, *mix_g, *mlp_g, *dn_w_in, *dn_conv_w, *dn_a_log, *dn_dt_bias, *dn_out_g, *dn_w_out, *mb_w_in, *mb_w_out, *w_up, *w_down, *final_g;
    float* out; unsigned char* ws;
};

struct EpiDnIn {
    static constexpr bool PERM = true, AFTER_DRAIN = false;
    bf16 *QK0, *ZV0;
    __device__ __forceinline__ void operator()(const pg8::f32x4 (&acc)[2][2][4][2], const pg8::Unit& u, int wr, int wc, int fr, int fq) const {
        const int row0 = u.pm * 256 + wr * 64 + fr;
        {
            const int ts = u.pn >> 2; bf16* base = (ts < 2) ? QK0 + (size_t)ts * M * D : ZV0 + (size_t)(3 - ts) * M * D;
            const int col0 = (u.pn & 3) * 256 + wc * 32 + 8 * fq;
#pragma unroll
            for (int ai = 0; ai < 2; ++ai)
#pragma unroll
                for (int m = 0; m < 4; ++m) { bf16* rowp = base + (size_t)(row0 + ai * 128 + m * 16) * D + col0;
#pragma unroll
                    for (int bj = 0; bj < 2; ++bj) { const pg8::f32x4 v0 = acc[ai][bj][m][0], v1 = acc[ai][bj][m][1];
                        v4u w; w.x = cvtpk(v0[0], v0[1]); w.y = cvtpk(v0[2], v0[3]); w.z = cvtpk(v1[0], v1[1]); w.w = cvtpk(v1[2], v1[3]);
                        *(v4u*)(rowp + bj * 128) = w; } }
        }
    }
};
struct EpiResid {
    static constexpr bool PERM = true, AFTER_DRAIN = false;
    const float* resid32; bf16* xb; float* ssq;
    __device__ __forceinline__ void operator()(const pg8::f32x4 (&acc)[2][2][4][2], const pg8::Unit& u, int wr, int wc, int fr, int fq) const {
        const int row0 = u.pm * 256 + wr * 64 + fr, col0 = u.pn * 256 + wc * 32 + 8 * fq;
#pragma unroll
        for (int ai = 0; ai < 2; ++ai)
#pragma unroll
            for (int m = 0; m < 4; ++m) { const int row = row0 + ai * 128 + m * 16; const size_t off = (size_t)row * D + col0; float ss = 0.f;
#pragma unroll
                for (int bj = 0; bj < 2; ++bj) { const size_t o2 = off + bj * 128; float r[8];
                    if (resid32) { const f32x4 a = *(const f32x4*)(resid32 + o2), c = *(const f32x4*)(resid32 + o2 + 4); r[0] = a[0]; r[1] = a[1]; r[2] = a[2]; r[3] = a[3]; r[4] = c[0]; r[5] = c[1]; r[6] = c[2]; r[7] = c[3]; }
                    else { const v4u q = *(const v4u*)(xb + o2); r[0] = __uint_as_float(q.x << 16); r[1] = __uint_as_float(q.x & 0xffff0000u); r[2] = __uint_as_float(q.y << 16); r[3] = __uint_as_float(q.y & 0xffff0000u);
                        r[4] = __uint_as_float(q.z << 16); r[5] = __uint_as_float(q.z & 0xffff0000u); r[6] = __uint_as_float(q.w << 16); r[7] = __uint_as_float(q.w & 0xffff0000u); }
                    const pg8::f32x4 v0 = acc[ai][bj][m][0], v1 = acc[ai][bj][m][1];
                    r[0] += v0[0]; r[1] += v0[1]; r[2] += v0[2]; r[3] += v0[3]; r[4] += v1[0]; r[5] += v1[1]; r[6] += v1[2]; r[7] += v1[3];
                    v4u w; w.x = cvtpk(r[0], r[1]); w.y = cvtpk(r[2], r[3]); w.z = cvtpk(r[4], r[5]); w.w = cvtpk(r[6], r[7]); *(v4u*)(xb + o2) = w;
                    ss += ((r[0] * r[0] + r[1] * r[1]) + (r[2] * r[2] + r[3] * r[3])) + ((r[4] * r[4] + r[5] * r[5]) + (r[6] * r[6] + r[7] * r[7])); }
                ss += __shfl_xor(ss, 16); ss += __shfl_xor(ss, 32);
                if (fq == 0) ssq[(size_t)row * 16 + u.pn * 4 + wc] = ss; }
    }
};
DI float rstd_from_ssq(const float* ssq, int row) {
    const f32x4 a = *(const f32x4*)(ssq + (size_t)row * 16), b = *(const f32x4*)(ssq + (size_t)row * 16 + 4), c = *(const f32x4*)(ssq + (size_t)row * 16 + 8), d = *(const f32x4*)(ssq + (size_t)row * 16 + 12);
    const float s = ((a[0] + a[1]) + (a[2] + a[3])) + ((b[0] + b[1]) + (b[2] + b[3])) + ((c[0] + c[1]) + (c[2] + c[3])) + ((d[0] + d[1]) + (d[2] + d[3]));
    return rsqrtf(s * (1.f / D) + RMS_EPS);
}
struct EpiUp {
    static constexpr bool PERM = true, AFTER_DRAIN = false;
    bf16* hid; const LAS float* rtab;
    __device__ __forceinline__ void operator()(const pg8::f32x4 (&acc)[2][2][4][2], const pg8::Unit& u, int wr, int wc, int fr, int fq) const {
        const int row0 = u.pm * 256 + wr * 64 + fr, col0 = u.pn * 256 + wc * 32 + 8 * fq;
#pragma unroll
        for (int ai = 0; ai < 2; ++ai)
#pragma unroll
            for (int m = 0; m < 4; ++m) { const int row = row0 + ai * 128 + m * 16; const float rs = rtab[u.ui * 256 + ai * 128 + wr * 64 + m * 16 + fr]; bf16* rowp = hid + (size_t)row * FF + col0;
#pragma unroll
                for (int bj = 0; bj < 2; ++bj) { pg8::f32x4 v0 = acc[ai][bj][m][0] * rs, v1 = acc[ai][bj][m][1] * rs;
#pragma unroll
                    for (int i = 0; i < 4; ++i) { const float a = fmaxf(v0[i], 0.f), b = fmaxf(v1[i], 0.f); v0[i] = a * a; v1[i] = b * b; }
                    v4u w; w.x = cvtpk(v0[0], v0[1]); w.y = cvtpk(v0[2], v0[3]); w.z = cvtpk(v1[0], v1[1]); w.w = cvtpk(v1[2], v1[3]);
                    *(v4u*)(rowp + bj * 128) = w; } }
    }
};
struct EpiMbIn {
    static constexpr bool PERM = true, AFTER_DRAIN = false;
    bf16 *QKV1; float* kpart; const LAS float* rtab; float* kn2;
    __device__ __forceinline__ void operator()(const pg8::f32x4 (&acc)[2][2][4][2], const pg8::Unit& u, int wr, int wc, int fr, int fq) const {
        const int row0 = u.pm * 256 + wr * 64 + fr; const int ts = u.pn >> 2; bf16* base = QKV1 + (size_t)ts * M * D;
        const int col0 = (u.pn & 3) * 256 + wc * 32 + 8 * fq; const float sc = ts == 0 ? QSCALE : 1.f;
        float cs[2][8];
#pragma unroll
        for (int bj = 0; bj < 2; ++bj)
#pragma unroll
            for (int i = 0; i < 8; ++i) cs[bj][i] = 0.f;
#pragma unroll
        for (int ai = 0; ai < 2; ++ai)
#pragma unroll
            for (int m = 0; m < 4; ++m) { const int row = row0 + ai * 128 + m * 16; const float rs = rtab[u.ui * 256 + ai * 128 + wr * 64 + m * 16 + fr] * sc; bf16* rowp = base + (size_t)row * D + col0;
#pragma unroll
                for (int bj = 0; bj < 2; ++bj) { const pg8::f32x4 v0 = acc[ai][bj][m][0] * rs, v1 = acc[ai][bj][m][1] * rs;
#pragma unroll
                    for (int i = 0; i < 4; ++i) { cs[bj][i] += v0[i]; cs[bj][4 + i] += v1[i]; }
                    v4u w; w.x = cvtpk(v0[0], v0[1]); w.y = cvtpk(v0[2], v0[3]); w.z = cvtpk(v1[0], v1[1]); w.w = cvtpk(v1[2], v1[3]);
                    *(v4u*)(rowp + bj * 128) = w;
                    if (ts == 1) { float ss = ((v0[0] * v0[0] + v0[1] * v0[1]) + (v0[2] * v0[2] + v0[3] * v0[3])) + ((v1[0] * v1[0] + v1[1] * v1[1]) + (v1[2] * v1[2] + v1[3] * v1[3]));
                        ss += __shfl_xor(ss, 16); ss += __shfl_xor(ss, 32);
                        if (fq == 0) atomicAdd(kn2 + (size_t)row * 8 + 2 * (u.pn & 3) + bj, ss); } } }
        if (ts == 1) {
#pragma unroll
            for (int bj = 0; bj < 2; ++bj)
#pragma unroll
                for (int i = 0; i < 8; ++i) { float s = cs[bj][i]; s += __shfl_xor(s, 1); s += __shfl_xor(s, 2); s += __shfl_xor(s, 4); s += __shfl_xor(s, 8); cs[bj][i] = s; }
            if (fr == 0) { float* dst = kpart + (size_t)(u.pm * 2 + wr) * D + col0;
#pragma unroll
                for (int bj = 0; bj < 2; ++bj) { *(f32x4*)(dst + bj * 128) = (f32x4){cs[bj][0], cs[bj][1], cs[bj][2], cs[bj][3]}; *(f32x4*)(dst + bj * 128 + 4) = (f32x4){cs[bj][4], cs[bj][5], cs[bj][6], cs[bj][7]}; } }
        }
    }
};

DI void p0_transpose_item(const float* W, int ldw, int K, const float* gk, bf16* WT, LAS float* scr, int item, int nblk, int lane) {
    const int kb = item / nblk, nb = item % nblk, k0 = 64 * kb, n0 = 32 * nb;
#pragma unroll 8
    for (int i = 0; i < 32; ++i) { const int kk = 2 * i + (lane >> 5); float w = W[(size_t)(k0 + kk) * ldw + n0 + (lane & 31)]; if (gk) w *= gk[k0 + kk]; scr[kk * 33 + (lane & 31)] = w; }
    LDS_WAIT(); asm volatile("" ::: "memory");
    const int c = lane & 7;
#pragma unroll
    for (int j = 0; j < 4; ++j) { const int n = (lane >> 3) + 8 * j; const LAS float* s = scr + (8 * c) * 33 + n;
        v4u o; o.x = cvtpk(s[0 * 33], s[1 * 33]); o.y = cvtpk(s[2 * 33], s[3 * 33]); o.z = cvtpk(s[4 * 33], s[5 * 33]); o.w = cvtpk(s[6 * 33], s[7 * 33]);
        *(GAS v4u*)(WT + (size_t)(n0 + n) * K + k0 + 8 * c) = o; }
    LDS_WAIT(); asm volatile("" ::: "memory");
}
DI void rms_row_to_bf16(const float* xrow, const float* gain, bf16* orow, int lane) {
    const GAS f32x4* xr = (const GAS f32x4*)xrow + lane; const GAS f32x4* gr = (const GAS f32x4*)gain + lane;
    f32x4 v[4]; float s = 0.f;
#pragma unroll
    for (int j = 0; j < 4; ++j) { v[j] = xr[64 * j]; s += (v[j].x * v[j].x + v[j].y * v[j].y) + (v[j].z * v[j].z + v[j].w * v[j].w); }
    const float rstd = rsqrtf(wave_sum(s) * (1.f / D) + RMS_EPS);
    GAS unsigned long long* o8 = (GAS unsigned long long*)orow + lane;
#pragma unroll
    for (int j = 0; j < 4; ++j) { const f32x4 gg = gr[64 * j]; o8[64 * j] = (unsigned long long)cvtpk(v[j].x * rstd * gg.x, v[j].y * rstd * gg.y) | ((unsigned long long)cvtpk(v[j].z * rstd * gg.z, v[j].w * rstd * gg.w) << 32); }
}
DI void p0_prologue(Frame& F) {
    LAS float* scr = (LAS float*)(F.lds + F.wave * 16384);
    const int gw = F.vcu * NWAVES + F.wave, NGW = F.G * NWAVES;
    bf16* const wdnin = (bf16*)(F.ws + WS_WDNIN);
    constexpr int I_DNIN = (D / 64) * (4096 / 32), I_SQ = (D / 64) * (D / 32), I_UP = (D / 64) * (FF / 32), I_DOWN = (FF / 64) * (D / 32);
    constexpr int NITEMS = I_DNIN + I_SQ + I_UP + I_DOWN;
    for (int it = gw; it < NITEMS; it += NGW) {
        int r = it;
        if (r < I_DNIN) { p0_transpose_item(F.dn_w_in, NDN, D, nullptr, wdnin, scr, r, 4096 / 32, F.lane); continue; } r -= I_DNIN;
        if (r < I_SQ) { p0_transpose_item(F.dn_w_out, D, D, nullptr, (bf16*)(F.ws + WS_WDNOUT), scr, r, D / 32, F.lane); continue; } r -= I_SQ;
        if (r < I_UP) { p0_transpose_item(F.w_up, FF, D, F.mlp_g, (bf16*)(F.ws + WS_WUP0), scr, r, FF / 32, F.lane); continue; } r -= I_UP;
        p0_transpose_item(F.w_down, D, FF, nullptr, (bf16*)(F.ws + WS_WDOWN0), scr, r, D / 32, F.lane);
    }
    const int gt = F.vcu * (NWAVES * 64) + F.tid, NGT = F.G * NWAVES * 64;
    for (int e = gt; e < 16 * D; e += NGT) { const int n = e >> 10, k = e & (D - 1); wdnin[(size_t)(4096 + n) * D + k] = (bf16)f2bf(F.dn_w_in[(size_t)k * NDN + 4096 + n]); }
    bf16* XN = (bf16*)(F.ws + WS_CH);
    for (int m = gw; m < M; m += NGW) rms_row_to_bf16(F.x + (size_t)m * D, F.mix_g, XN + (size_t)m * D, F.lane);
}
DI void p0b_layer1_weights(Frame& F, int w, int nw) {
    LAS float* scr = (LAS float*)(F.lds + F.wave * 16384);
    const int gw = w * NWAVES + F.wave, NGW = nw * NWAVES;
    constexpr int I_SQ = (D / 64) * (D / 32), I_UP = (D / 64) * (FF / 32), I_DOWN = (FF / 64) * (D / 32), I_MBIN = (D / 64) * (NMB / 32);
    constexpr int NITEMS = I_MBIN + I_SQ + I_UP + I_DOWN;
    for (int it = gw; it < NITEMS; it += NGW) {
        int r = it;
        if (r < I_MBIN) { p0_transpose_item(F.mb_w_in, NMB, D, F.mix_g + D, (bf16*)(F.ws + WS_WMBIN), scr, r, NMB / 32, F.lane); continue; } r -= I_MBIN;
        if (r < I_SQ) { p0_transpose_item(F.mb_w_out, D, D, nullptr, (bf16*)(F.ws + WS_WMBOUT), scr, r, D / 32, F.lane); continue; } r -= I_SQ;
        if (r < I_UP) { p0_transpose_item(F.w_up + (size_t)D * FF, FF, D, F.mlp_g + D, (bf16*)(F.ws + WS_WUP1), scr, r, FF / 32, F.lane); continue; } r -= I_UP;
        p0_transpose_item(F.w_down + (size_t)FF * D, D, FF, nullptr, (bf16*)(F.ws + WS_WDOWN1), scr, r, D / 32, F.lane);
    }
}
DI void p1_beta_g(Frame& F) {
    const int lane = F.lane, fr = lane & 15, fq = lane >> 4;
    const bf16* XN = (const bf16*)(F.ws + WS_CH); const bf16* W16 = (const bf16*)(F.ws + WS_WDNIN) + (size_t)4096 * D;
    float* beta = (float*)(F.ws + WS_BETA); float* g = (float*)(F.ws + WS_G);
    for (int rt = F.vcu * NWAVES + F.wave; rt < M / 16; rt += F.G * NWAVES) {
        const bf16* ap = XN + (size_t)(rt * 16 + fr) * D + 8 * fq; const bf16* bp = W16 + (size_t)fr * D + 8 * fq;
        f32x4 acc0 = {0.f, 0.f, 0.f, 0.f}, acc1 = {0.f, 0.f, 0.f, 0.f};
#pragma unroll 4
        for (int ks = 0; ks < 32; ks += 2) { const bf16x8 a0 = *(const bf16x8*)(ap + 32 * ks), b0 = *(const bf16x8*)(bp + 32 * ks), a1 = *(const bf16x8*)(ap + 32 * ks + 32), b1 = *(const bf16x8*)(bp + 32 * ks + 32);
            acc0 = MFMA16(a0, b0, acc0); acc1 = MFMA16(a1, b1, acc1); }
        const int n = fr; const float al = -__expf(F.dn_a_log[n & 7]), db = F.dn_dt_bias[n & 7];
#pragma unroll
        for (int rg = 0; rg < 4; ++rg) { const float v = acc0[rg] + acc1[rg]; const size_t row = (size_t)rt * 16 + 4 * fq + rg;
            if (n < 8) beta[row * 8 + n] = sigmoidf_(v); else g[row * 8 + (n - 8)] = al * softplusf_(v + db); }
    }
}
DI void p_final(Frame& F) {
    const int gw = F.vcu * NWAVES + F.wave, NGW = F.G * NWAVES; const float* ssq = (const float*)(F.ws + WS_SSQ + 3 * 2 * MiB); const bf16* xb = (const bf16*)(F.ws + WS_K0);
    f32x4 gg[4];
#pragma unroll
    for (int j = 0; j < 4; ++j) gg[j] = *((const GAS f32x4*)F.final_g + 2 * F.lane + (j & 1) + 128 * (j >> 1));
#pragma unroll 2
    for (int m = gw; m < M; m += NGW) {
        const float rs = rstd_from_ssq(ssq, m);
#pragma unroll
        for (int hf = 0; hf < 2; ++hf) { const v4u q = *(const v4u*)(xb + (size_t)m * D + 512 * hf + 8 * F.lane);
            f32x4 a = {__uint_as_float(q.x << 16), __uint_as_float(q.x & 0xffff0000u), __uint_as_float(q.y << 16), __uint_as_float(q.y & 0xffff0000u)};
            f32x4 c = {__uint_as_float(q.z << 16), __uint_as_float(q.z & 0xffff0000u), __uint_as_float(q.w << 16), __uint_as_float(q.w & 0xffff0000u)};
            a = a * rs; a = a * gg[2 * hf]; c = c * rs; c = c * gg[2 * hf + 1];
            GAS f32x4* op = (GAS f32x4*)(F.out + (size_t)m * D + 512 * hf + 8 * F.lane); op[0] = a; op[1] = c; }
    }
}
DI void stagger(int quarter_ticks) {
    const int g = ((int)blockIdx.x >> 3) & 3;
    if (g) { const unsigned long long t0 = __builtin_amdgcn_s_memrealtime(); const unsigned long long d = (unsigned long long)(g * quarter_ticks);
        while (__builtin_amdgcn_s_memrealtime() - t0 < d) __builtin_amdgcn_s_sleep(8); }
}
constexpr int RTAB_OFF = 131072;
template <class Sched> DI void fill_rtab(Frame& F, const Sched& S, const float* ssq) {
    LAS float* rtab = (LAS float*)(F.lds + RTAB_OFF); pg8::Unit u;
    for (int i = 0; i < 8 && S.next(i, u); ++i) if (F.tid < 256) rtab[i * 256 + F.tid] = rstd_from_ssq(ssq, u.pm * 256 + F.tid);
    __syncthreads();
}

namespace attn {
constexpr int KP = 136, VP = 160;
constexpr int LDS_K = 0, LDS_V = 2 * 64 * KP * 2, LDS_KM = LDS_K  , LDS_Q = LDS_V + 3 * 64 * VP * 2, LDS_END = LDS_Q + 8 * 8 * 1024;
static_assert(LDS_END <= MISC_OFF, "attention LDS");
constexpr float THR = 8.f;
typedef short v4i16_t __attribute__((ext_vector_type(4)));
DI s16x4 vtr(const LAS bf16* p) { return __builtin_bit_cast(s16x4, __builtin_amdgcn_ds_read_tr16_b64_v4i16((LAS v4i16_t*)p)); }
DI void attn_unit(int b, int h, int qb, const bf16* Q, const bf16* K, const bf16* V, const float* kpart, const float* kn2, bf16* O, LAS unsigned char* lds, int tid) {
    const int lane = tid & 63, wid = __builtin_amdgcn_readfirstlane(tid >> 6), r = lane & 31, hh = lane >> 5;
    const size_t rowbase = (size_t)b * T;
    LAS bf16* KM = (LAS bf16*)(lds + LDS_KM);
    for (int e = tid; e < 32 * 128; e += NWAVES * 64) { const int j = e >> 7, d = e & 127; float v = 0.f;
        if (j < qb) { const float* p = kpart + ((size_t)(b * 16 + j) * 2) * D + h * HD + d; v = (p[0] + p[D]) * (1.f / 256.f); }
        KM[j * KP + d] = f2bfq(v); }
    const bf16* qrow = Q + (rowbase + qb * 256 + wid * 32 + r) * D + h * HD + hh * 8;
    bf16x8 qf[8];
#pragma unroll
    for (int ks = 0; ks < 8; ++ks) qf[ks] = *(const bf16x8*)(qrow + ks * 16);
    LAS bf16* Qs = (LAS bf16*)(lds + LDS_Q) + wid * 4096 + lane * 8;
#pragma unroll
    for (int ks = 0; ks < 8; ++ks) *(LAS bf16x8*)(Qs + ks * 512) = qf[ks];
    { float q2 = 0.f;
#pragma unroll
      for (int ks = 0; ks < 8; ++ks)
#pragma unroll
          for (int e = 0; e < 8; ++e) { const float v = bf2f((unsigned short)qf[ks][e]); q2 += v * v; }
      q2 += __shfl_xor(q2, 32);
      float k2 = 0.f;
      for (int t = tid; t < 256 * (qb + 1); t += NWAVES * 64) k2 = fmaxf(k2, kn2[(rowbase + t) * 8 + h]);
#pragma unroll
      for (int o_ = 1; o_ < 64; o_ <<= 1) { q2 = fmaxf(q2, __shfl_xor(q2, o_)); k2 = fmaxf(k2, __shfl_xor(k2, o_)); }
      if (lane == 0) { LAS float* nb = (LAS float*)(lds + MISC_OFF + 128); nb[wid] = q2; nb[8 + wid] = k2; } }
    __syncthreads();
    f32x16 gt;
#pragma unroll
    for (int i = 0; i < 16; ++i) gt[i] = 0.f;
#pragma unroll
    for (int ks = 0; ks < 8; ++ks) { const bf16x8 a = *(const LAS bf16x8*)(KM + r * KP + ks * 16 + hh * 8); gt = MFMA32(a, qf[ks], gt); }
    float sc[16];
#pragma unroll
    for (int i = 0; i < 8; ++i) { const float own = gt[i], oth = __shfl_xor(own, 32); const int blo = 8 * (i >> 2) + (i & 3);
        sc[blo] = hh ? oth : own; sc[blo + 4] = hh ? own : oth; }
    unsigned mask = 0u;
#pragma unroll
    for (int rep = 0; rep < 3; ++rep) { float best = -INFINITY; int bi = -1;
#pragma unroll
        for (int j = 0; j < 16; ++j) { const bool ok = (j < qb) && !((mask >> j) & 1u) && (sc[j] > best); best = ok ? sc[j] : best; bi = ok ? j : bi; }
        if (bi >= 0) mask |= 1u << bi; }
    LBAR();
    const float slope2 = exp2f(-(float)(h + 1)) * LOG2E;
    const float tq_rel = (float)(wid * 32 + r);
    bf16x8 aext0, aext1, bext;
    { const unsigned shi = f2bf(slope2), slo = f2bf(slope2 - bf2f((unsigned short)shi)); const unsigned p0w = f2bf((float)r), p1w = f2bf((float)(32 + r));
      v4u a0 = {0u, 0u, 0u, 0u}, a1 = {0u, 0u, 0u, 0u}, bq = {0u, 0u, 0u, 0u};
      if (hh == 0) { a0.x = p0w | (p0w << 16); a1.x = p1w | (p1w << 16); bq.x = shi | (slo << 16); }
      aext0 = __builtin_bit_cast(bf16x8, a0); aext1 = __builtin_bit_cast(bf16x8, a1); bext = __builtin_bit_cast(bf16x8, bq); }
    float mrun = -1e30f, lrun = 0.f; f32x16 o[4];
#pragma unroll
    for (int dt = 0; dt < 4; ++dt)
#pragma unroll
        for (int i = 0; i < 16; ++i) o[dt][i] = 0.f;
    const int ntile = 4 * (qb + 1);
    v4u kreg[2], vreg[2];
    const char* Kh = (const char*)(K + rowbase * D + h * HD); const char* Vh = (const char*)(V + rowbase * D + h * HD);
    const unsigned goff = (unsigned)(((tid >> 4) * D + 8 * (tid & 15)) * 2);
    const int soffK = (tid >> 4) * KP + 8 * (tid & 15), soffV = (tid >> 4) * VP + 8 * (tid & 15);
#define ATT_LOAD(kt_) do { const char* kb_ = Kh + (size_t)(kt_) * (64 * D * 2); const char* vb_ = Vh + (size_t)(kt_) * (64 * D * 2); \
        kreg[0] = *(const v4u*)(kb_ + goff); kreg[1] = *(const v4u*)(kb_ + goff + 32 * D * 2); vreg[0] = *(const v4u*)(vb_ + goff); vreg[1] = *(const v4u*)(vb_ + goff + 32 * D * 2); } while (0)
#define ATT_WRITE(kslot_, vslot_) do { LAS bf16* ks_ = (LAS bf16*)(lds + LDS_K) + (kslot_) * 64 * KP; LAS bf16* vs_ = (LAS bf16*)(lds + LDS_V) + (vslot_) * 64 * VP; \
        *(LAS v4u*)(ks_ + soffK) = kreg[0]; *(LAS v4u*)(ks_ + soffK + 32 * KP) = kreg[1]; *(LAS v4u*)(vs_ + soffV) = vreg[0]; *(LAS v4u*)(vs_ + soffV + 32 * VP) = vreg[1]; } while (0)
#define ATT_QK(kslot_) do { const LAS bf16* Ks_ = (const LAS bf16*)(lds + LDS_K) + (kslot_) * 64 * KP + r * KP + hh * 8; \
        _Pragma("unroll") for (int i_ = 0; i_ < 16; ++i_) { p0[i_] = 0.f; p1[i_] = 0.f; } \
        p0 = MFMA32(aext0, bext, p0); p1 = MFMA32(aext1, bext, p1); \
        _Pragma("unroll") for (int ks_ = 0; ks_ < 8; ++ks_) { const bf16x8 a0_ = *(const LAS bf16x8*)(Ks_ + ks_ * 16), a1_ = *(const LAS bf16x8*)(Ks_ + 32 * KP + ks_ * 16); \
            const bf16x8 q_ = *(const LAS bf16x8*)(Qs + ks_ * 512); p0 = MFMA32(a0_, q_, p0); p1 = MFMA32(a1_, q_, p1); if ((ks_ & 1) == 1) __builtin_amdgcn_sched_barrier(0); } } while (0)
#define ATT_SM(kt_) do { const int j_ = (kt_) >> 2, tk0_ = 64 * ((kt_) & 3); const bool own_ = (j_ == qb); const bool sel_ = own_ || ((mask >> j_) & 1u); \
        const float cl_ = sel_ ? slope2 * ((float)(256 * (j_ - qb) + tk0_) - tq_rel) : -INFINITY; \
        if (own_ && tk0_ + 63 > wid * 32) { const float kb0_ = (float)(tk0_ + 4 * hh); \
            _Pragma("unroll") for (int i_ = 0; i_ < 16; ++i_) { const float cr_ = (float)((i_ & 3) + 8 * (i_ >> 2)); if (kb0_ + cr_ > tq_rel) p0[i_] = -INFINITY; if (kb0_ + cr_ + 32.f > tq_rel) p1[i_] = -INFINITY; } } \
        float mx_ = -INFINITY; \
        _Pragma("unroll") for (int i_ = 0; i_ < 16; ++i_) mx_ = fmaxf(mx_, fmaxf(p0[i_], p1[i_])); \
        { const auto rr_ = __builtin_amdgcn_permlane32_swap(__float_as_uint(mx_), __float_as_uint(mx_), false, false); mx_ = fmaxf(__uint_as_float(rr_[0]), __uint_as_float(rr_[1])) + cl_; } \
        if (__any(mx_ > mrun + THR)) { const float mnew_ = fmaxf(mrun, mx_); const float alpha_ = __builtin_amdgcn_exp2f(mrun - mnew_); mrun = mnew_; lrun *= alpha_; \
            _Pragma("unroll") for (int dt_ = 0; dt_ < 4; ++dt_) _Pragma("unroll") for (int i_ = 0; i_ < 16; ++i_) o[dt_][i_] *= alpha_; } \
        const float off_ = mrun - cl_; float rs_ = 0.f; \
        _Pragma("unroll") for (int i_ = 0; i_ < 16; ++i_) { p0[i_] = __builtin_amdgcn_exp2f(p0[i_] - off_); p1[i_] = __builtin_amdgcn_exp2f(p1[i_] - off_); rs_ += p0[i_] + p1[i_]; } \
        lrun += rs_; \
        _Pragma("unroll") for (int s_ = 0; s_ < 2; ++s_) { v4u w0_, w1_; \
            w0_.x = cvtpk(p0[8 * s_ + 0], p0[8 * s_ + 1]); w0_.y = cvtpk(p0[8 * s_ + 2], p0[8 * s_ + 3]); w0_.z = cvtpk(p0[8 * s_ + 4], p0[8 * s_ + 5]); w0_.w = cvtpk(p0[8 * s_ + 6], p0[8 * s_ + 7]); \
            w1_.x = cvtpk(p1[8 * s_ + 0], p1[8 * s_ + 1]); w1_.y = cvtpk(p1[8 * s_ + 2], p1[8 * s_ + 3]); w1_.z = cvtpk(p1[8 * s_ + 4], p1[8 * s_ + 5]); w1_.w = cvtpk(p1[8 * s_ + 6], p1[8 * s_ + 7]); \
            pb[0][s_] = __builtin_bit_cast(bf16x8, w0_); pb[1][s_] = __builtin_bit_cast(bf16x8, w1_); } } while (0)
#define ATT_PV(vslot_) do { const LAS bf16* vb_ = (const LAS bf16*)(lds + LDS_V) + (vslot_) * 64 * VP + vlane; \
        _Pragma("unroll") for (int dt_ = 0; dt_ < 4; ++dt_) { \
            _Pragma("unroll") for (int kh_ = 0; kh_ < 2; ++kh_) _Pragma("unroll") for (int s_ = 0; s_ < 2; ++s_) { const LAS bf16* vp_ = vb_ + (32 * kh_ + 16 * s_) * VP + 32 * dt_; \
                const s16x4 lo_ = vtr(vp_), hi_ = vtr(vp_ + 8 * VP); const bf16x8 a_ = __builtin_shufflevector(lo_, hi_, 0, 1, 2, 3, 4, 5, 6, 7); o[dt_] = MFMA32(a_, pb[kh_][s_], o[dt_]); } \
            __builtin_amdgcn_sched_barrier(0); } } while (0)
    const int vlane = (4 * hh + ((lane & 15) >> 2)) * VP + 16 * ((lane >> 4) & 1) + 4 * (lane & 3);
    const bool late = wid >= 4;
    f32x16 p0, p1; bf16x8 pb[2][2]; bool pend = false; int vs_prev = 0;
    int kt0 = 0; { const LAS float* nb = (const LAS float*)(lds + MISC_OFF + 128); float q2 = 0.f, k2 = 0.f;
#pragma unroll
        for (int w_ = 0; w_ < 8; ++w_) { q2 = fmaxf(q2, nb[w_]); k2 = fmaxf(k2, nb[8 + w_]); }
        const float D0 = (151.f + 2.f * sqrtf(q2 * k2) * 1.01f) / slope2; const float first = (256.f * qb - D0 - 63.f) * (1.f / 64.f); if (first > 0.f) kt0 = (int)first; if (kt0 > 4 * qb) kt0 = 4 * qb; }
    ATT_LOAD(kt0);
    int ksl = 0, vsl = 0;
    for (int kt = kt0; kt < ntile; ++kt) {
        ATT_WRITE(ksl, vsl);
        LBAR();
        if (kt + 1 < ntile) ATT_LOAD(kt + 1);
        const int j = kt >> 2; const bool own = (j == qb); const bool sel = own || ((mask >> j) & 1u);
        const bool skip = (__ballot(sel) == 0ull) || (own && 64 * (kt & 3) > wid * 32 + 31);
        if (pend) { ATT_PV(vs_prev); pend = false; }
        if (!skip) { ATT_QK(ksl); ATT_SM(kt);
            if (late) { pend = true; vs_prev = vsl; } else ATT_PV(vsl); }
        ksl ^= 1; vsl = (vsl == 2) ? 0 : vsl + 1;
    }
    if (pend) ATT_PV(vs_prev);
#undef ATT_LOAD
#undef ATT_WRITE
#undef ATT_QK
#undef ATT_SM
#undef ATT_PV
    lrun += __shfl_xor(lrun, 32);
    const float inv = 1.f / lrun;
    bf16* orow = O + (rowbase + qb * 256 + wid * 32 + r) * D + h * HD + 4 * hh;
#pragma unroll
    for (int dt = 0; dt < 4; ++dt)
#pragma unroll
        for (int g = 0; g < 4; ++g) { u32x2 w; w.x = cvtpk(o[dt][4 * g] * inv, o[dt][4 * g + 1] * inv); w.y = cvtpk(o[dt][4 * g + 2] * inv, o[dt][4 * g + 3] * inv);
            *(u32x2*)(orow + 32 * dt + 8 * g) = w; }
    __syncthreads();
}
DI void attn_phase(Frame& F, const bf16* Q, const bf16* K, const bf16* V, const float* kpart, const float* kn2, bf16* O) {
    volatile LAS int* slot = (volatile LAS int*)(F.lds + MISC_OFF + 64);
    for (;;) {
        if (F.tid == 0) slot[0] = (int)__hip_atomic_fetch_add((unsigned*)(F.ctl + CW_ATTQ), 1u, __ATOMIC_RELAXED, __HIP_MEMORY_SCOPE_AGENT);
        __syncthreads();
        const int u = slot[0];
        if (u >= BATCH * H * 16) break;
        const int qb = 15 - (u >> 6), h = 7 - ((u >> 3) & 7), b = u & 7;
        attn_unit(b, h, qb, Q, K, V, kpart, kn2, O, F.lds, F.tid);
    }
}
}

#ifndef USE_REF_DELTA
#define USE_REF_DELTA 0
#endif
#ifndef MK_ONE_LAUNCH
#define MK_ONE_LAUNCH 1
#endif
#if USE_REF_DELTA
__global__ void __launch_bounds__(512) ref_conv(const bf16* q0, const bf16* k0, const bf16* v0, const float* conv_w, bf16* outc) {
    const int m = blockIdx.x / 3, ts = blockIdx.x % 3, tid = threadIdx.x, t = m % T;
    const bf16* src = ts == 0 ? q0 : ts == 1 ? k0 : v0;
    float y[2];
#pragma unroll
    for (int e = 0; e < 2; ++e) { const int c = 2 * tid + e; float a = 0.f;
#pragma unroll
        for (int j = 0; j < 4; ++j) { const int tt = t - 3 + j; if (tt >= 0) a += conv_w[(size_t)j * 3 * D + ts * D + c] * bf2f(src[(size_t)(m - 3 + j) * D + c]); }
        y[e] = siluf_(a); }
    if (ts < 2) { const float ss = wave_sum(y[0] * y[0] + y[1] * y[1]); float rn = rsqrtf(ss + 1e-6f); if (ts == 0) rn *= 0.08838834764831845f; y[0] *= rn; y[1] *= rn; }
    *(unsigned*)(outc + (size_t)ts * M * D + (size_t)m * D + 2 * tid) = cvtpk(y[0], y[1]);
}
__global__ void __launch_bounds__(256) ref_delta(const bf16* qkvc, const bf16* z, const float* beta, const float* gl, const float* out_g, bf16* a0) {
    __shared__ float ks[128], qs[128], red[2][128], red2[2][128], wsum[2];
    const int b = blockIdx.x >> 3, h = blockIdx.x & 7, tid = threadIdx.x, dvi = tid & 127, half = tid >> 7;
    const bf16* qc = qkvc + h * HD; const bf16* kc = qkvc + (size_t)M * D + h * HD; const bf16* vc = qkvc + 2 * (size_t)M * D + h * HD;
    float S[64];
#pragma unroll
    for (int i = 0; i < 64; ++i) S[i] = 0.f;
    const float og = out_g[dvi];
    for (int t = 0; t < T; ++t) {
        const size_t m = (size_t)b * T + t;
        if (tid < 128) ks[tid] = bf2f(kc[m * D + tid]); else qs[tid - 128] = bf2f(qc[m * D + tid - 128]);
        const float v = bf2f(vc[m * D + dvi]); const float bt = beta[m * 8 + h], eg = __expf(gl[m * 8 + h]);
        __syncthreads();
        float part = 0.f;
#pragma unroll
        for (int i = 0; i < 64; ++i) { S[i] *= eg; part += ks[half * 64 + i] * S[i]; }
        red[half][dvi] = part;
        __syncthreads();
        const float delta = bt * (v - (red[0][dvi] + red[1][dvi]));
        float po = 0.f;
#pragma unroll
        for (int i = 0; i < 64; ++i) { S[i] += ks[half * 64 + i] * delta; po += qs[half * 64 + i] * S[i]; }
        red2[half][dvi] = po;
        __syncthreads();
        float o = 0.f;
        if (half == 0) { o = red2[0][dvi] + red2[1][dvi]; const float ss = wave_sum(o * o); if ((tid & 63) == 0) wsum[tid >> 6] = ss; }
        __syncthreads();
        if (half == 0) { const float rstd = rsqrtf((wsum[0] + wsum[1]) * (1.f / HD) + RMS_EPS); const float zz = bf2f(z[m * D + h * HD + dvi]);
            a0[m * D + h * HD + dvi] = (bf16)f2bf(o * rstd * og * siluf_(zz)); }
    }
}
DI void p2_chunks(Frame&) {}
DI void p3_scan(Frame& F) { p0b_layer1_weights(F, F.vcu, F.G); }
DI void p3b_gate(Frame& F) { GAS v4u* z4 = (GAS v4u*)(F.ws + WS_BETA); for (int e = F.vcu * (NWAVES * 64) + F.tid; e < M * 8 / 4; e += F.G * NWAVES * 64) z4[e] = (v4u){0u, 0u, 0u, 0u}; }
#endif

#if !USE_REF_DELTA
namespace p2 {
constexpr int KP = 136, TP = 72, AP = 68;
constexpr int L_KN = 0, L_QN = 17408, L_RT = 34816, L_KDT = 71680, L_AM = 90112, L_TM = 107520, L_TB = 124928, L_AT = 134144, L_GC = 143360, L_CW = 144384, L_END = 150528;
static_assert(L_END <= MISC_OFF, "P2 LDS");
struct Raw { v4u r[3][5]; float g, bt; };
DI void decode(int q, int& b, int& h, int& n) { h = q & 7; const int rest = q >> 3; b = rest >> 6; n = rest & 63; }
DI void load_raw(Frame& F, int q, Raw& R) {
    int b, h, n; decode(q, b, h, n);
    const int tid = F.tid, grp = tid >> 4, cl = tid & 15, t0 = n * CL;
    const bf16* qk0 = (const bf16*)(F.ws + WS_Q0); const bf16* v0 = (const bf16*)((const unsigned char*)F.out + 64 * MiB);
#pragma unroll
    for (int ts = 0; ts < 3; ++ts) { const bf16* src = (ts < 2 ? qk0 + (size_t)ts * M * D : v0) + h * HD + 8 * cl;
#pragma unroll
        for (int j = 0; j < 5; ++j) { const int tt = t0 + 2 * grp - 3 + j;
            R.r[ts][j] = (tt >= 0) ? *(const v4u*)(src + ((size_t)b * T + tt) * D) : (v4u){0u, 0u, 0u, 0u}; } }
    if (F.wave == 0) { const size_t m0 = (size_t)b * T + (size_t)n * CL; R.g = ((const float*)(F.ws + WS_G))[(m0 + F.lane) * 8 + h]; R.bt = ((const float*)(F.ws + WS_BETA))[(m0 + F.lane) * 8 + h]; }
}
DI void p2_run(Frame& F) {
    const int tid = F.tid, lane = F.lane, wave = F.wave, fr = lane & 15, fq = lane >> 4;
    LAS bf16* KN = (LAS bf16*)(F.lds + L_KN); LAS bf16* QN = (LAS bf16*)(F.lds + L_QN); LAS bf16* RT = (LAS bf16*)(F.lds + L_RT); LAS bf16* KDT = (LAS bf16*)(F.lds + L_KDT);
    LAS float* AM = (LAS float*)(F.lds + L_AM); LAS float* TM = (LAS float*)(F.lds + L_TM); LAS bf16* TB = (LAS bf16*)(F.lds + L_TB); LAS bf16* AT = (LAS bf16*)(F.lds + L_AT);
    LAS float* GC = (LAS float*)(F.lds + L_GC);
    LAS float* CW = (LAS float*)(F.lds + L_CW);
    int hprev = -1;
    Raw R;
    if (F.vcu < BATCH * H * NCH) load_raw(F, F.vcu, R);
#pragma unroll 1
    for (int q = F.vcu; q < BATCH * H * NCH; q += F.G) {
    int b, h, n; decode(q, b, h, n);
    const int item = (b * H + h) * NCH + n;
    unsigned char* chb = F.ws + WS_CH + (size_t)item * CH_BYTES;
    if (h != hprev) {
        for (int e = tid; e < 3 * 4 * 128; e += NWAVES * 64) { const int ts = e >> 9, jt = (e >> 7) & 3, c = e & 127; CW[e] = F.dn_conv_w[(size_t)jt * 3 * D + ts * D + h * HD + c]; }
        hprev = h;
    }
    if (wave == 0) {
        float g = R.g;
#pragma unroll
        for (int o = 1; o < 64; o <<= 1) { const float t = __shfl_up(g, o); if (lane >= o) g += t; }
        const float gl = __shfl(g, 63);
        GC[lane] = g; GC[64 + lane] = __expf(g); GC[128 + lane] = __expf(gl - g); GC[192 + lane] = R.bt;
        if (lane == 63) ((float*)(F.ws + WS_GTOT))[item] = __expf(g);
    }
    LBAR();
    {
        const int grp = tid >> 4, cl = tid & 15, tk0 = 2 * grp;
        const int tpos = (((tk0 >> 3) ^ (cl & 7)) << 3) + (tk0 & 7);
#pragma unroll
        for (int ts = 0; ts < 3; ++ts) {
            float y[2][8];
#pragma unroll
            for (int it = 0; it < 2; ++it) {
#pragma unroll
                for (int e = 0; e < 8; ++e) y[it][e] = 0.f;
#pragma unroll
                for (int j = 0; j < 4; ++j) { const v4u raw = R.r[ts][it + j]; const f32x4 wa = *(const LAS f32x4*)(CW + (ts * 4 + j) * 128 + 8 * cl), wb = *(const LAS f32x4*)(CW + (ts * 4 + j) * 128 + 8 * cl + 4);
                    y[it][0] += wa[0] * __uint_as_float(raw.x << 16); y[it][1] += wa[1] * __uint_as_float(raw.x & 0xffff0000u);
                    y[it][2] += wa[2] * __uint_as_float(raw.y << 16); y[it][3] += wa[3] * __uint_as_float(raw.y & 0xffff0000u);
                    y[it][4] += wb[0] * __uint_as_float(raw.z << 16); y[it][5] += wb[1] * __uint_as_float(raw.z & 0xffff0000u);
                    y[it][6] += wb[2] * __uint_as_float(raw.w << 16); y[it][7] += wb[3] * __uint_as_float(raw.w & 0xffff0000u); }
                float ss = 0.f;
#pragma unroll
                for (int e = 0; e < 8; ++e) { y[it][e] = siluf_(y[it][e]); ss += y[it][e] * y[it][e]; }
                if (ts < 2) { ss = sum16(ss);
                    float rn = rsqrtf(ss + 1e-6f); if (ts == 0) rn *= 0.08838834764831845f;
#pragma unroll
                    for (int e = 0; e < 8; ++e) y[it][e] *= rn; }
            }
            const float eg0 = GC[64 + tk0], eg1 = GC[65 + tk0], ek0 = GC[128 + tk0], ek1 = GC[129 + tk0], bt0 = GC[192 + tk0], bt1 = GC[193 + tk0];
            if (ts == 0) {
#pragma unroll
                for (int it = 0; it < 2; ++it) { const float eg = it ? eg1 : eg0; const int tk = tk0 + it;
                    v4u a; a.x = cvtpk(y[it][0], y[it][1]); a.y = cvtpk(y[it][2], y[it][3]); a.z = cvtpk(y[it][4], y[it][5]); a.w = cvtpk(y[it][6], y[it][7]);
                    *(LAS v4u*)(QN + tk * KP + 8 * cl) = a;
                    v4u d; d.x = cvtpk(y[it][0] * eg, y[it][1] * eg); d.y = cvtpk(y[it][2] * eg, y[it][3] * eg); d.z = cvtpk(y[it][4] * eg, y[it][5] * eg); d.w = cvtpk(y[it][6] * eg, y[it][7] * eg);
                    *(v4u*)(chb + CH_QD + (size_t)(tk * 128 + 8 * cl) * 2) = d; }
            } else if (ts == 1) {
#pragma unroll
                for (int it = 0; it < 2; ++it) { const int tk = tk0 + it;
                    v4u a; a.x = cvtpk(y[it][0], y[it][1]); a.y = cvtpk(y[it][2], y[it][3]); a.z = cvtpk(y[it][4], y[it][5]); a.w = cvtpk(y[it][6], y[it][7]);
                    *(LAS v4u*)(KN + tk * KP + 8 * cl) = a; }
                const float be0 = bt0 * eg0, be1 = bt1 * eg1;
#pragma unroll
                for (int e = 0; e < 8; ++e) { *(LAS unsigned*)(KDT + (8 * cl + e) * TP + tpos) = cvtpk(y[0][e] * ek0, y[1][e] * ek1); *(LAS unsigned*)(RT + (128 + 8 * cl + e) * TP + tpos) = cvtpk(y[0][e] * be0, y[1][e] * be1); }
            } else {
#pragma unroll
                for (int e = 0; e < 8; ++e) *(LAS unsigned*)(RT + (8 * cl + e) * TP + tpos) = cvtpk(y[0][e] * bt0, y[1][e] * bt1);
            }
        }
    }
    LBAR();
    if (q + F.G < BATCH * H * NCH) load_raw(F, q + F.G, R);
    {
        const int mat = wave >> 2, rt = wave & 3; const LAS bf16* As = mat ? QN : KN;
#pragma unroll 2
        for (int ct = 0; ct < 4; ++ct) {
            f32x4 acc = {0.f, 0.f, 0.f, 0.f};
            if (ct <= rt) {
#pragma unroll
                for (int ks = 0; ks < 4; ++ks) { const bf16x8 a = *(const LAS bf16x8*)(As + (16 * rt + fr) * KP + 32 * ks + 8 * fq), bb = *(const LAS bf16x8*)(KN + (16 * ct + fr) * KP + 32 * ks + 8 * fq);
                    acc = MFMA16(a, bb, acc); }
            }
            const int j = 16 * ct + fr; const float gj = GC[j];
#pragma unroll
            for (int rg = 0; rg < 4; ++rg) { const int i = 16 * rt + 4 * fq + rg; const float dec = __expf(fminf(GC[i] - gj, 0.f));
                if (mat == 0) { if (ct <= rt) AM[i * AP + j] = (i > j) ? GC[192 + i] * acc[rg] * dec : 0.f; }
                else AT[i * TP + j] = f2bfq((i >= j) ? acc[rg] * dec : 0.f); }
        }
    }
    LBAR();
    if (wave == 0) {
        const int blk = lane >> 4, c = lane & 15; float tc[16];
#pragma unroll
        for (int r = 0; r < 16; ++r) { float t = (r == c) ? 1.f : 0.f; const LAS float* ar = AM + (16 * blk + r) * AP + 16 * blk;
#pragma unroll
            for (int j4 = 0; j4 < (r + 3) / 4; ++j4) { const f32x4 a = *(const LAS f32x4*)(ar + 4 * j4);
#pragma unroll
                for (int e = 0; e < 4; ++e) if (4 * j4 + e < r) t -= a[e] * tc[4 * j4 + e]; }
            tc[r] = t; TM[(16 * blk + r) * AP + 16 * blk + c] = t; }
    }
    LBAR();
#pragma unroll 1
    for (int i = 1; i < 4; ++i) {
        if (wave < i) { const int j = wave; f32x4 x = {0.f, 0.f, 0.f, 0.f};
            for (int k = j; k < i; ++k)
#pragma unroll
                for (int ks = 0; ks < 4; ++ks) x = __builtin_amdgcn_mfma_f32_16x16x4f32(AM[(16 * i + fr) * AP + 16 * k + 4 * ks + fq], TM[(16 * k + 4 * ks + fq) * AP + 16 * j + fr], x, 0, 0, 0);
            f32x4 y = {0.f, 0.f, 0.f, 0.f};
#pragma unroll
            for (int rho = 0; rho < 4; ++rho) y = __builtin_amdgcn_mfma_f32_16x16x4f32(TM[(16 * i + fr) * AP + 16 * i + 4 * fq + rho], x[rho], y, 0, 0, 0);
#pragma unroll
            for (int rg = 0; rg < 4; ++rg) TM[(16 * i + 4 * fq + rg) * AP + 16 * j + fr] = -y[rg]; }
        LBAR();
    }
    { const int i = tid >> 3, c8 = tid & 7; const f32x4 a = *(const LAS f32x4*)(TM + i * AP + 8 * c8), c = *(const LAS f32x4*)(TM + i * AP + 8 * c8 + 4);
      v4u o; o.x = cvtpk(a[0], a[1]); o.y = cvtpk(a[2], a[3]); o.z = cvtpk(c[0], c[1]); o.w = cvtpk(c[2], c[3]);
      if ((c8 >> 1) > (i >> 4)) o = (v4u){0u, 0u, 0u, 0u};
      *(LAS v4u*)(TB + i * TP + 8 * c8) = o; }
    LBAR();
#pragma unroll 4
    for (int e = 0; e < 8; ++e) { const int ti = wave * 8 + e;
        if (ti < 32) { const int rt = ti >> 3, ct = ti & 7; f32x4 acc = {0.f, 0.f, 0.f, 0.f}; const int sw = (2 * ct + (fr >> 3)) & 7;
#pragma unroll
            for (int ks = 0; ks < 2; ++ks) { const bf16x8 a = *(const LAS bf16x8*)(TB + (16 * rt + fr) * TP + 32 * ks + 8 * fq), bb = *(const LAS bf16x8*)(RT + (16 * ct + fr) * TP + (((4 * ks + fq) ^ sw) << 3)); acc = MFMA16(a, bb, acc); }
            u32x2 o; o.x = cvtpk(acc[0], acc[1]); o.y = cvtpk(acc[2], acc[3]);
            *(u32x2*)(chb + CH_U + (size_t)((16 * ct + fr) * 64 + 16 * rt + 4 * fq) * 2) = o;
        } else { const int ct = (ti - 32) >> 2, rt = (ti - 32) & 3; f32x4 acc = {0.f, 0.f, 0.f, 0.f}; const int sw = (2 * ct + (fr >> 3)) & 7;
#pragma unroll
            for (int ks = 0; ks < 2; ++ks) { const bf16x8 a = *(const LAS bf16x8*)(RT + (128 + 16 * ct + fr) * TP + (((4 * ks + fq) ^ sw) << 3)), bb = *(const LAS bf16x8*)(TB + (16 * rt + fr) * TP + 32 * ks + 8 * fq); acc = MFMA16(a, bb, acc); }
            u32x2 o; o.x = cvtpk(-acc[0], -acc[1]); o.y = cvtpk(-acc[2], -acc[3]);
            *(u32x2*)(chb + CH_W + (size_t)((16 * rt + fr) * 128 + 16 * ct + 4 * fq) * 2) = o; }
    }
    { const int row = tid >> 3, c8 = tid & 7; *(v4u*)(chb + CH_AT + (size_t)(row * 64 + 8 * c8) * 2) = *(const LAS v4u*)(AT + row * TP + 8 * c8);
#pragma unroll
      for (int e = 0; e < 2; ++e) { const int idx = tid + 512 * e, r2 = idx >> 3, c2 = idx & 7; *(v4u*)(chb + CH_KD + (size_t)(r2 * 64 + 8 * c2) * 2) = *(const LAS v4u*)(KDT + r2 * TP + ((c2 ^ ((r2 >> 3) & 7)) << 3)); } }
    LBAR();
    }
}
}
DI void p2_chunks(Frame& F) { p2::p2_run(F); }

namespace p3 {
constexpr int WP = 136, TP = 72;
constexpr int O_W = 0, O_QD = 17408, O_KD = 34816, O_AT = 53248, OPB = 62464, L_OB = 2 * OPB, OBB = 17408, L_END = L_OB + 2 * OBB;
static_assert(L_END + 512 <= MISC_OFF, "P3 LDS");
DI int pi32(int x) { return (x & ~12) | ((x & 4) << 1) | ((x & 8) >> 1); }
DI bf16x8 pack8(const f32x16& x, int s) { v4u w; w.x = cvtpk(x[8 * s], x[8 * s + 1]); w.y = cvtpk(x[8 * s + 2], x[8 * s + 3]); w.z = cvtpk(x[8 * s + 4], x[8 * s + 5]); w.w = cvtpk(x[8 * s + 6], x[8 * s + 7]); return __builtin_bit_cast(bf16x8, w); }
DI void scan_item(Frame& F, int item) {
    const int tid = F.tid, lane = F.lane, wave = F.wave;
    const int h = item & 7, b = item >> 3;
    const unsigned char* chbase = F.ws + WS_CH + (size_t)item * NCH * CH_BYTES;
    const float* gtot = (const float*)(F.ws + WS_GTOT) + item * NCH;
    LAS unsigned char* lds = F.lds;
    if (wave < 4) {
        const int rho = lane & 31, hh = lane >> 5, c0 = 32 * wave, prow = pi32(rho);
        f32x16 S[4];
#pragma unroll
        for (int t = 0; t < 4; ++t)
#pragma unroll
            for (int i = 0; i < 16; ++i) S[t][i] = 0.f;
        v4u ucur[2][2];
        const float gtv = gtot[lane];
        { const bf16* up = (const bf16*)(chbase + CH_U) + (c0 + rho) * 64 + 8 * hh;
#pragma unroll
          for (int r = 0; r < 2; ++r)
#pragma unroll
              for (int s = 0; s < 2; ++s) ucur[r][s] = *(const v4u*)(up + 32 * r + 16 * s); }
        LBAR();
#pragma unroll 1
        for (int n = 0; n < NCH; ++n) {
            const LAS bf16* Wl = (const LAS bf16*)(lds + (n & 1) * OPB + O_W) + prow * WP + 8 * hh; const LAS bf16* QDl = (const LAS bf16*)(lds + (n & 1) * OPB + O_QD) + rho * WP + 8 * hh;
            const LAS bf16* KDl = (const LAS bf16*)(lds + (n & 1) * OPB + O_KD) + prow * TP + 8 * hh; const LAS bf16* ATl = (const LAS bf16*)(lds + (n & 1) * OPB + O_AT) + rho * TP + 8 * hh;
            LAS bf16* OBl = (LAS bf16*)(lds + L_OB + (n & 1) * OBB);
            const float gt = __uint_as_float(__builtin_amdgcn_readlane(__float_as_uint(gtv), n));
            f32x16 vn[2], o[2];
#pragma unroll
            for (int r = 0; r < 2; ++r) {
#pragma unroll
                for (int s = 0; s < 2; ++s) { const v4u q = ucur[r][s];
                    vn[r][8 * s + 0] = __uint_as_float(q.x << 16); vn[r][8 * s + 1] = __uint_as_float(q.x & 0xffff0000u); vn[r][8 * s + 2] = __uint_as_float(q.y << 16); vn[r][8 * s + 3] = __uint_as_float(q.y & 0xffff0000u);
                    vn[r][8 * s + 4] = __uint_as_float(q.z << 16); vn[r][8 * s + 5] = __uint_as_float(q.z & 0xffff0000u); vn[r][8 * s + 6] = __uint_as_float(q.w << 16); vn[r][8 * s + 7] = __uint_as_float(q.w & 0xffff0000u); }
#pragma unroll
                for (int i = 0; i < 16; ++i) o[r][i] = 0.f; }
            asm volatile("" : "+v"(vn[0]), "+v"(vn[1]) :: "memory");
            if (n + 1 < NCH) { const bf16* up = (const bf16*)(chbase + (size_t)(n + 1) * CH_BYTES + CH_U) + (c0 + rho) * 64 + 8 * hh;
#pragma unroll
                for (int r = 0; r < 2; ++r)
#pragma unroll
                    for (int s = 0; s < 2; ++s) ucur[r][s] = *(const v4u*)(up + 32 * r + 16 * s); }
#define SB() __builtin_amdgcn_sched_barrier(0)
            bf16x8 fa[8], fb[8];
#define P3_LDF(dst, t) do { _Pragma("unroll") for (int s_ = 0; s_ < 2; ++s_) { dst[4 * s_ + 0] = *(const LAS bf16x8*)(Wl + 32 * (t) + 16 * s_); dst[4 * s_ + 1] = *(const LAS bf16x8*)(Wl + 32 * WP + 32 * (t) + 16 * s_); \
                dst[4 * s_ + 2] = *(const LAS bf16x8*)(QDl + 32 * (t) + 16 * s_); dst[4 * s_ + 3] = *(const LAS bf16x8*)(QDl + 32 * WP + 32 * (t) + 16 * s_); } } while (0)
#define P3_MM8(f, t) do { _Pragma("unroll") for (int s_ = 0; s_ < 2; ++s_) { const bf16x8 sb_ = pack8(S[t], s_); vn[0] = MFMA32(f[4 * s_ + 0], sb_, vn[0]); vn[1] = MFMA32(f[4 * s_ + 1], sb_, vn[1]); o[0] = MFMA32(f[4 * s_ + 2], sb_, o[0]); o[1] = MFMA32(f[4 * s_ + 3], sb_, o[1]); } } while (0)
            P3_LDF(fa, 0); SB();
            P3_LDF(fb, 1); SB(); P3_MM8(fa, 0); SB();
            P3_LDF(fa, 2); SB(); P3_MM8(fb, 1); SB();
            P3_LDF(fb, 3); SB(); P3_MM8(fa, 2); SB();
            fa[0] = *(const LAS bf16x8*)(ATl); fa[1] = *(const LAS bf16x8*)(ATl + 16); fa[2] = *(const LAS bf16x8*)(ATl + 32 * TP); fa[3] = *(const LAS bf16x8*)(ATl + 32 * TP + 16);
            fa[4] = *(const LAS bf16x8*)(ATl + 32 * TP + 32); fa[5] = *(const LAS bf16x8*)(ATl + 32 * TP + 48); fa[6] = *(const LAS bf16x8*)(KDl); fa[7] = *(const LAS bf16x8*)(KDl + 16);
            SB(); P3_MM8(fb, 3); SB();
#undef P3_LDF
#undef P3_MM8
            bf16x8 vnb[2][2];
#pragma unroll
            for (int r = 0; r < 2; ++r)
#pragma unroll
                for (int s = 0; s < 2; ++s) vnb[r][s] = pack8(vn[r], s);
            fb[0] = *(const LAS bf16x8*)(KDl + 32); fb[1] = *(const LAS bf16x8*)(KDl + 48);
#pragma unroll
            for (int e = 0; e < 4; ++e) fb[2 + e] = *(const LAS bf16x8*)(KDl + 32 * TP + 16 * e);
            fb[6] = *(const LAS bf16x8*)(KDl + 64 * TP); fb[7] = *(const LAS bf16x8*)(KDl + 64 * TP + 16);
            SB();
            o[0] = MFMA32(fa[0], vnb[0][0], o[0]); o[1] = MFMA32(fa[2], vnb[0][0], o[1]); o[0] = MFMA32(fa[1], vnb[0][1], o[0]); o[1] = MFMA32(fa[3], vnb[0][1], o[1]);
            o[1] = MFMA32(fa[4], vnb[1][0], o[1]); o[1] = MFMA32(fa[5], vnb[1][1], o[1]);
#pragma unroll
            for (int i = 0; i < 16; ++i) S[0][i] *= gt;
            S[0] = MFMA32(fa[6], vnb[0][0], S[0]); S[0] = MFMA32(fa[7], vnb[0][1], S[0]);
            SB();
            fa[0] = *(const LAS bf16x8*)(KDl + 64 * TP + 32); fa[1] = *(const LAS bf16x8*)(KDl + 64 * TP + 48);
#pragma unroll
            for (int e = 0; e < 4; ++e) fa[2 + e] = *(const LAS bf16x8*)(KDl + 96 * TP + 16 * e);
            SB();
            S[0] = MFMA32(fb[0], vnb[1][0], S[0]); S[0] = MFMA32(fb[1], vnb[1][1], S[0]);
#pragma unroll
            for (int i = 0; i < 16; ++i) S[1][i] *= gt;
            S[1] = MFMA32(fb[2], vnb[0][0], S[1]); S[1] = MFMA32(fb[3], vnb[0][1], S[1]); S[1] = MFMA32(fb[4], vnb[1][0], S[1]); S[1] = MFMA32(fb[5], vnb[1][1], S[1]);
#pragma unroll
            for (int i = 0; i < 16; ++i) S[2][i] *= gt;
            S[2] = MFMA32(fb[6], vnb[0][0], S[2]); S[2] = MFMA32(fb[7], vnb[0][1], S[2]);
            SB();
            S[2] = MFMA32(fa[0], vnb[1][0], S[2]); S[2] = MFMA32(fa[1], vnb[1][1], S[2]);
#pragma unroll
            for (int i = 0; i < 16; ++i) S[3][i] *= gt;
            S[3] = MFMA32(fa[2], vnb[0][0], S[3]); S[3] = MFMA32(fa[3], vnb[0][1], S[3]); S[3] = MFMA32(fa[4], vnb[1][0], S[3]); S[3] = MFMA32(fa[5], vnb[1][1], S[3]);
#undef SB
#pragma unroll
            for (int rp = 0; rp < 2; ++rp)
#pragma unroll
                for (int i = 0; i < 16; ++i) OBl[(32 * rp + (i & 3) + 8 * (i >> 2) + 4 * hh) * WP + c0 + rho] = f2bfq(o[rp][i]);
            LBAR();
        }
    } else {
        const int pair = (wave - 4) >> 1, pl = tid - 256 - 128 * pair;
        bf16* obuf = (bf16*)(F.ws + WS_K0);
        v4u RA[28];
#define P3_LOAD(nn) do { const unsigned char* cb_ = chbase + (size_t)(nn) * CH_BYTES + (size_t)pl * 16; \
            _Pragma("unroll") for (int e_ = 0; e_ < 28; ++e_) RA[e_] = *(const v4u*)(cb_ + (size_t)e_ * 2048 + (e_ >= 8 ? 16384 : 0)); } while (0)
#define P3_WRITE(bufi) do { LAS unsigned char* ob_ = lds + (bufi) * OPB; \
            _Pragma("unroll") for (int e_ = 0; e_ < 28; ++e_) { \
                if (e_ < 8) { const int l_ = pl + 128 * e_; *(LAS v4u*)(ob_ + O_W + ((l_ >> 4) * WP + 8 * (l_ & 15)) * 2) = RA[e_]; } \
                else if (e_ < 16) { const int l_ = pl + 128 * (e_ - 8); *(LAS v4u*)(ob_ + O_QD + ((l_ >> 4) * WP + 8 * (l_ & 15)) * 2) = RA[e_]; } \
                else if (e_ < 24) { const int l_ = pl + 128 * (e_ - 16); *(LAS v4u*)(ob_ + O_KD + ((l_ >> 3) * TP + 8 * (l_ & 7)) * 2) = RA[e_]; } \
                else { const int l_ = pl + 128 * (e_ - 24); *(LAS v4u*)(ob_ + O_AT + ((l_ >> 3) * TP + 8 * (l_ & 7)) * 2) = RA[e_]; } } } while (0)
#define P3_OCOPY(nn) do { const LAS bf16* ob_ = (const LAS bf16*)(lds + L_OB + ((nn) & 1) * OBB); bf16* og_ = obuf + ((size_t)b * T + (size_t)(nn) * CL) * D + h * HD; \
            _Pragma("unroll") for (int e_ = 0; e_ < 8; ++e_) { const int idx_ = pl + 128 * e_; *(v4u*)(og_ + (size_t)(idx_ >> 4) * D + 8 * (idx_ & 15)) = *(const LAS v4u*)(ob_ + (idx_ >> 4) * WP + 8 * (idx_ & 15)); } } while (0)
        if (pair == 0) { P3_LOAD(0); P3_WRITE(0); asm volatile("" ::: "memory"); P3_LOAD(2); } else { P3_LOAD(1); }
        LBAR();
#pragma unroll 1
        for (int n = 0; n < NCH; n += 2) {
            if (pair == 1) { P3_WRITE(1); asm volatile("" ::: "memory"); if (n + 3 < NCH) P3_LOAD(n + 3); }
            else if (n >= 1) P3_OCOPY(n - 1);
            LBAR();
            if (pair == 0) { if (n + 2 < NCH) { P3_WRITE(0); asm volatile("" ::: "memory"); if (n + 4 < NCH) P3_LOAD(n + 4); } }
            else P3_OCOPY(n);
            LBAR();
        }
        if (pair == 0) P3_OCOPY(NCH - 1);
#undef P3_LOAD
#undef P3_WRITE
#undef P3_OCOPY
    }
    LBAR();
}
}
DI void p3b_gate(Frame& F) {
    const int gw = F.vcu * NWAVES + F.wave, NGW = F.G * NWAVES, lane = F.lane;
    { GAS v4u* z4 = (GAS v4u*)(F.ws + WS_BETA); for (int e = F.vcu * (NWAVES * 64) + F.tid; e < M * 8 / 4; e += F.G * NWAVES * 64) z4[e] = (v4u){0u, 0u, 0u, 0u}; }
    const bf16* ob = (const bf16*)(F.ws + WS_K0); const bf16* zb = (const bf16*)F.out; bf16* a0 = (bf16*)(F.ws + WS_Q0);
    float og[16];
#pragma unroll
    for (int e = 0; e < 4; ++e) { const f32x4 a = *(const f32x4*)(F.dn_out_g + (lane & 7) * 16 + 4 * e); og[4 * e] = a[0]; og[4 * e + 1] = a[1]; og[4 * e + 2] = a[2]; og[4 * e + 3] = a[3]; }
#pragma unroll 2
    for (int m = gw; m < M; m += NGW) {
        const size_t off = (size_t)m * D + lane * 16;
        const v4u o0 = *(const v4u*)(ob + off), o1 = *(const v4u*)(ob + off + 8), z0 = *(const v4u*)(zb + off), z1 = *(const v4u*)(zb + off + 8);
        const unsigned ow[8] = {o0.x, o0.y, o0.z, o0.w, o1.x, o1.y, o1.z, o1.w}, zw[8] = {z0.x, z0.y, z0.z, z0.w, z1.x, z1.y, z1.z, z1.w};
        float of[16], ss = 0.f;
#pragma unroll
        for (int k = 0; k < 8; ++k) { of[2 * k] = __uint_as_float(ow[k] << 16); of[2 * k + 1] = __uint_as_float(ow[k] & 0xffff0000u); ss += of[2 * k] * of[2 * k] + of[2 * k + 1] * of[2 * k + 1]; }
        ss += __shfl_xor(ss, 1); ss += __shfl_xor(ss, 2); ss += __shfl_xor(ss, 4);
        const float rs = rsqrtf(ss * (1.f / HD) + RMS_EPS);
        unsigned rw[8];
#pragma unroll
        for (int k = 0; k < 8; ++k) rw[k] = cvtpk(of[2 * k] * rs * og[2 * k] * siluf_(__uint_as_float(zw[k] << 16)), of[2 * k + 1] * rs * og[2 * k + 1] * siluf_(__uint_as_float(zw[k] & 0xffff0000u)));
        *(v4u*)(a0 + off) = (v4u){rw[0], rw[1], rw[2], rw[3]}; *(v4u*)(a0 + off + 8) = (v4u){rw[4], rw[5], rw[6], rw[7]};
    }
}
DI void p3_scan(Frame& F) { if ((int)blockIdx.x < BATCH * H) p3::scan_item(F, (int)blockIdx.x); else p0b_layer1_weights(F, (int)blockIdx.x - BATCH * H, F.G - BATCH * H); }
#endif

struct Args { const float* in[14]; float* out; unsigned char* ws; int ph_lo, ph_hi, var, pad; };
static_assert(sizeof(Args) == 14 * 8 + 8 + 8 + 16, "Args has no padding");
constexpr int N_PHASES = 14;
#ifndef STAG_UP
#define STAG_UP 800
#endif
#ifndef REP_LIST
#define REP_LIST {1,1,1,1,1,1,1,1,1,1,1,1,1,1}
#endif
constexpr int REP[14] = REP_LIST;
#ifndef HREP_LIST
#define HREP_LIST {1,1,1,1,1,1,1,1,1,1,1,1,1,1}
#endif
static const int HREP[14] = HREP_LIST;
__global__ void __launch_bounds__(NWAVES * 64, 2) fwd(Args args) {
    extern __shared__ __attribute__((aligned(16))) unsigned char lds_raw[];
    Frame F;
    F.lds = (LAS unsigned char*)lds_raw;
    F.MISC = (volatile LAS unsigned*)(F.lds + MISC_OFF);
    F.tid = threadIdx.x; F.lane = F.tid & 63; F.wave = __builtin_amdgcn_readfirstlane(F.tid >> 6);
    F.G = gridDim.x; { const int bx = blockIdx.x; F.vcu = (F.G % 8 == 0) ? (bx % 8) * (F.G / 8) + bx / 8 : bx; }
    F.ws = args.ws; F.ctl = (gu32*)(args.ws + WS_CTL); F.out = args.out;
    F.x = args.in[0]; F.mix_g = args.in[1]; F.mlp_g = args.in[2]; F.dn_w_in = args.in[3]; F.dn_conv_w = args.in[4]; F.dn_a_log = args.in[5]; F.dn_dt_bias = args.in[6];
    F.dn_out_g = args.in[7]; F.dn_w_out = args.in[8]; F.mb_w_in = args.in[9]; F.mb_w_out = args.in[10]; F.w_up = args.in[11]; F.w_down = args.in[12]; F.final_g = args.in[13];
    for (int u = F.tid; u < (LDS_BYTES - MISC_OFF) / 4; u += NWAVES * 64) ((LAS unsigned*)(F.lds + MISC_OFF))[u] = 0u;
    __syncthreads();
    const int lo = args.ph_lo, hi = args.ph_hi; F.var = args.var;
    const bool multi = (hi - lo) > 1;
    XcdBarrier bar; bar.bar = (unsigned*)(F.ctl + CW_BAR); bar.x = 0; bar.st = nullptr;
    if (multi) bar = xcd_barrier_post((unsigned*)(F.ctl + CW_BAR), F.MISC + 8);
#define IN(k) (lo <= (k) && (k) < hi)
#define SEAM(k) do { if (IN(k) && IN((k) + 1)) xcd_barrier(bar); } while (0)
    unsigned char* const ws = args.ws;
    bf16* const Q0 = (bf16*)(ws + WS_Q0); bf16* const XB = (bf16*)(ws + WS_K0); bf16* const CHB = (bf16*)(ws + WS_CH);
    bf16* const Zb = (bf16*)args.out; bf16* const V0 = (bf16*)((unsigned char*)args.out + 64 * MiB);
    float* const ssq = (float*)(ws + WS_SSQ); constexpr size_t SSQ_STRIDE = (size_t)M * 16;
    float* const kpart = (float*)(ws + WS_KPART);

    if (IN(0)) for (int rep_ = 0; rep_ < REP[0]; ++rep_) { p0_prologue(F); } SEAM(0);
    if (IN(1)) for (int rep_ = 0; rep_ < REP[1]; ++rep_) {
        pg8::Gemm g{CHB, (const bf16*)(ws + WS_WDNIN), M, 4 * D, D}; pg8::StaticOrder S; S.init(M, 4 * D, F.G, (int)blockIdx.x);
        EpiDnIn E{Q0, Zb};
        pg8::gemm_phase<EpiDnIn, pg8::StaticOrder, true, true>(F.lds, g, S, E);
        p1_beta_g(F);
    } SEAM(1);
    if (IN(2)) for (int rep_ = 0; rep_ < REP[2]; ++rep_) { p2_chunks(F); } SEAM(2);
    if (IN(3)) for (int rep_ = 0; rep_ < REP[3]; ++rep_) { p3_scan(F); } SEAM(3);
    if (IN(4)) for (int rep_ = 0; rep_ < REP[4]; ++rep_) { p3b_gate(F); } SEAM(4);
    if (IN(5)) for (int rep_ = 0; rep_ < REP[5]; ++rep_) {
        pg8::Gemm g{Q0, (const bf16*)(ws + WS_WDNOUT), M, D, D}; pg8::StaticOrder S; S.init(M, D, F.G, (int)blockIdx.x);
        EpiResid E{F.x, XB, ssq + 0 * SSQ_STRIDE};
        pg8::gemm_phase<EpiResid, pg8::StaticOrder, true, true>(F.lds, g, S, E);
    } SEAM(5);
    if (IN(6)) for (int rep_ = 0; rep_ < REP[6]; ++rep_) {
        pg8::Gemm g{XB, (const bf16*)(ws + WS_WUP0), M, FF, D}; pg8::StaticOrder S; S.init(M, FF, F.G, (int)blockIdx.x);
        fill_rtab(F, S, ssq + 0 * SSQ_STRIDE); EpiUp E{CHB, (const LAS float*)(F.lds + RTAB_OFF)};
        pg8::gemm_phase<EpiUp, pg8::StaticOrder, true, true>(F.lds, g, S, E);
    } SEAM(6);
    if (IN(7)) for (int rep_ = 0; rep_ < REP[7]; ++rep_) {
        pg8::Gemm g{CHB, (const bf16*)(ws + WS_WDOWN0), M, D, FF}; pg8::StaticOrder S; S.init(M, D, F.G, (int)blockIdx.x);
        EpiResid E{nullptr, XB, ssq + 1 * SSQ_STRIDE};
        pg8::gemm_phase<EpiResid, pg8::StaticOrder, true, true>(F.lds, g, S, E);
    } SEAM(7);
    bf16* const Q1 = CHB; bf16* const K1 = (bf16*)(ws + WS_CH + 64 * MiB); bf16* const V1 = (bf16*)(ws + WS_CH + 128 * MiB);
    if (IN(8)) for (int rep_ = 0; rep_ < REP[8]; ++rep_) {
        pg8::Gemm g{XB, (const bf16*)(ws + WS_WMBIN), M, NMB, D}; pg8::StaticOrder S; S.init(M, NMB, F.G, (int)blockIdx.x);
        fill_rtab(F, S, ssq + 1 * SSQ_STRIDE); EpiMbIn E{Q1, kpart, (const LAS float*)(F.lds + RTAB_OFF), (float*)(ws + WS_BETA)};
        pg8::gemm_phase<EpiMbIn, pg8::StaticOrder, true, true>(F.lds, g, S, E);
    } SEAM(8);
    if (IN(9)) for (int rep_ = 0; rep_ < REP[9]; ++rep_) { attn::attn_phase(F, Q1, K1, V1, kpart, (const float*)(ws + WS_BETA), Q0); } SEAM(9);
    if (IN(10)) for (int rep_ = 0; rep_ < REP[10]; ++rep_) {
        pg8::Gemm g{Q0, (const bf16*)(ws + WS_WMBOUT), M, D, D}; pg8::StaticOrder S; S.init(M, D, F.G, (int)blockIdx.x);
        EpiResid E{nullptr, XB, ssq + 2 * SSQ_STRIDE};
        pg8::gemm_phase<EpiResid, pg8::StaticOrder, true, true>(F.lds, g, S, E);
    } SEAM(10);
    if (IN(11)) for (int rep_ = 0; rep_ < REP[11]; ++rep_) {
        pg8::Gemm g{XB, (const bf16*)(ws + WS_WUP1), M, FF, D}; pg8::StaticOrder S; S.init(M, FF, F.G, (int)blockIdx.x);
        fill_rtab(F, S, ssq + 2 * SSQ_STRIDE); EpiUp E{CHB, (const LAS float*)(F.lds + RTAB_OFF)};
        pg8::gemm_phase<EpiUp, pg8::StaticOrder, true, true>(F.lds, g, S, E);
    } SEAM(11);
    if (IN(12)) for (int rep_ = 0; rep_ < REP[12]; ++rep_) {
        pg8::Gemm g{CHB, (const bf16*)(ws + WS_WDOWN1), M, D, FF}; pg8::StaticOrder S; S.init(M, D, F.G, (int)blockIdx.x);
        EpiResid E{nullptr, XB, ssq + 3 * SSQ_STRIDE};
        pg8::gemm_phase<EpiResid, pg8::StaticOrder, true, true>(F.lds, g, S, E);
    } SEAM(12);
    if (IN(13)) for (int rep_ = 0; rep_ < REP[13]; ++rep_) { p_final(F); }
#undef IN
#undef SEAM
}

extern "C" void kernel_launch(void* const* d_in, const int* in_sizes, int n_in, void* d_out, int out_size, void* d_ws, size_t ws_size, hipStream_t stream) {
    static int grid = 0;
    if (grid == 0) {
        if (n_in != 14 || in_sizes[0] != M * D || out_size != M * D || ws_size < WS_END) { fprintf(stderr, "kernel_launch: unexpected shapes (n_in %d, in0 %d, out %d, ws %zu)\n", n_in, n_in > 0 ? in_sizes[0] : -1, out_size, ws_size); grid = -1; return; }
        int dev = 0, cus = 0, per_cu = 0;
        if (hipGetDevice(&dev) != hipSuccess || hipDeviceGetAttribute(&cus, hipDeviceAttributeMultiprocessorCount, dev) != hipSuccess) { grid = -1; return; }
        if (hipFuncSetAttribute((const void*)fwd, hipFuncAttributeMaxDynamicSharedMemorySize, LDS_BYTES) != hipSuccess) { fprintf(stderr, "kernel_launch: hipFuncSetAttribute failed\n"); grid = -1; return; }
        if (hipOccupancyMaxActiveBlocksPerMultiprocessor(&per_cu, (const void*)fwd, NWAVES * 64, LDS_BYTES) != hipSuccess || per_cu < 1) fprintf(stderr, "kernel_launch: occupancy query says %d\n", per_cu);
        (void)hipGetLastError();
        grid = cus;
    }
    if (grid < 0) return;
    (void)hipMemsetAsync((char*)d_ws + WS_CTL, 0, CTL_ZERO_BYTES, stream);
    Args a{};
    for (int i = 0; i < 14; ++i) a.in[i] = (const float*)d_in[i];
    a.out = (float*)d_out; a.ws = (unsigned char*)d_ws;
#if MK_ONE_LAUNCH
    a.ph_lo = 0; a.ph_hi = N_PHASES;
    hipLaunchKernelGGL(fwd, dim3(grid), dim3(NWAVES * 64), LDS_BYTES, stream, a);
#else
    for (int ph = 0; ph < N_PHASES; ++ph) {
#if USE_REF_DELTA
        if (ph == 2) { hipLaunchKernelGGL(ref_conv, dim3(M * 3), dim3(512), 0, stream, (const bf16*)((char*)d_ws + WS_Q0), (const bf16*)((char*)d_ws + WS_K0), (const bf16*)((char*)d_out + 64 * MiB),
                                          (const float*)d_in[4], (bf16*)((char*)d_ws + WS_CH)); continue; }
        if (ph == 3) { hipLaunchKernelGGL(ref_delta, dim3(BATCH * H), dim3(256), 0, stream, (const bf16*)((char*)d_ws + WS_CH), (const bf16*)d_out, (const float*)((char*)d_ws + WS_BETA), (const float*)((char*)d_ws + WS_G),
                                          (const float*)d_in[7], (bf16*)((char*)d_ws + WS_Q0)); continue; }
#endif
        a.ph_lo = ph; a.ph_hi = ph + 1;
#ifdef PROBE_PHASE
        if (ph == PROBE_PHASE) { a.var = PROBE_VAR; hipLaunchKernelGGL(fwd, dim3(grid), dim3(NWAVES * 64), LDS_BYTES, stream, a); a.var = 0; }
#endif
        for (int r_ = 0; r_ < HREP[ph]; ++r_) hipLaunchKernelGGL(fwd, dim3(grid), dim3(NWAVES * 64), LDS_BYTES, stream, a);
    }
#endif
}
```

```cpp
#include <hip/hip_runtime.h>
#include <cstdio>
#include <cstdint>
#include <cmath>
#define USE_REF_DELTA 0
#define MK_ONE_LAUNCH 1
namespace pg8 {
#define PG8_LAS __attribute__((address_space(3)))
typedef unsigned short bf16_t;
typedef short bf16x8 __attribute__((ext_vector_type(8)));
typedef float f32x4 __attribute__((ext_vector_type(4)));
typedef unsigned u32x4 __attribute__((ext_vector_type(4)));
constexpr int BM = 256, BK = 64, HALF = 128, HTB = HALF * BK * 2  , STAGE_BYTES = 8 * HTB, NXCD = 8, WGM = 4;

__host__ __device__ __forceinline__ int lds_byte(int r, int c) { const int st = (r >> 4) * 2 + (c >> 5), rr = r & 15, cc = c & 31, ob = rr * 64 + cc * 2; return st * 1024 + (ob ^ (((ob >> 9) & 1) << 5)); }
__host__ __device__ __forceinline__ void stage_rc(int b, int& R, int& C) { const int st = b / 1024, sb = b % 1024, swz = sb ^ (((sb >> 9) & 1) << 5); R = (st >> 1) * 16 + swz / 64; C = (st & 1) * 32 + (swz % 64) / 2; }
__host__ __device__ __forceinline__ int perm32(int rho) { const int n = rho >> 4, i = rho & 15; return 8 * (i >> 2) + 4 * n + (i & 3); }

struct Unit { int pm, pn, ui; };
struct Gemm { const bf16_t* A; const bf16_t* Bt; int M, N, K; };

struct StaticOrder {
    int nM, nN, nwg, G, c;
    __host__ __device__ void init(int M, int N, int G_, int c_) { nM = M / BM; nN = N / BM; nwg = nM * nN; G = G_; c = c_; }
    __host__ __device__ bool next(int i, Unit& u) const {
        const long L = (long)i * G + c; if (L >= nwg) return false;
        int wgid = (int)L; { const int q = nwg / NXCD, r = nwg % NXCD, xcd = wgid % NXCD, off = wgid / NXCD; wgid = (xcd < r ? xcd * (q + 1) : r * (q + 1) + (xcd - r) * q) + off; }
        const int nig = WGM * nN, gid = wgid / nig, fm = gid * WGM, gsz = (nM - fm) < WGM ? (nM - fm) : WGM;
        u.pm = fm + ((wgid % nig) % gsz); u.pn = (wgid % nig) / gsz; u.ui = i; return true;
    }
    __device__ __forceinline__ void a_ready(const Unit&) const {}
    __device__ __forceinline__ void done(const Unit&) const {}
};

__device__ __forceinline__ unsigned cvt_pk_bf16(float lo, float hi) { unsigned r; asm volatile("v_cvt_pk_bf16_f32 %0, %1, %2" : "=v"(r) : "v"(lo), "v"(hi)); return r; }
typedef float f32x2 __attribute__((ext_vector_type(2)));
template <class Epi, class Sched, bool ALIGN_EPI = false, bool SP2 = false>
__device__ __forceinline__ void gemm_phase(PG8_LAS unsigned char* lds, const Gemm g, const Sched& S, const Epi& E) {
    const int tid = threadIdx.x, wid = __builtin_amdgcn_readfirstlane(tid >> 6), lane = tid & 63, wr = wid >> 2, wc = wid & 3, fr = lane & 15, fq = lane >> 4;
    const int K = g.K, nt = K / BK;
    unsigned voffA[2], voffB[2];
#pragma unroll
    for (int i = 0; i < 2; ++i) { int R, C; stage_rc(tid * 16 + i * 8192, R, C); const int Rb = Epi::PERM ? ((R & ~31) + perm32(R & 31)) : R;
        voffA[i] = (unsigned)(R * K + C) * 2u; voffB[i] = (unsigned)(Rb * K + C) * 2u; }
    const size_t kstep = (size_t)(BK * 2);
    const size_t hstep = (size_t)HALF * K * 2;
    const size_t tstep = 2 * hstep;
    const unsigned ldsw = (unsigned)wid * 1024u;
    const int aoff = lds_byte(wr * 64 + fr, fq * 8), boff = lds_byte(wc * 32 + fr, fq * 8);
#define PG8_SA(b, h) (((b) * 2 + (h)) * HTB)
#define PG8_SB(b, h) ((4 + (b) * 2 + (h)) * HTB)
#define PG8_STAGE(bufoff, gbase, voff) do { _Pragma("unroll") for (int _i = 0; _i < 2; ++_i) \
        __builtin_amdgcn_global_load_lds((const unsigned*)((const char*)(gbase) + (voff)[_i]), (PG8_LAS unsigned*)(lds + (bufoff) + ldsw + _i * 8192), 16, 0, 0); } while (0)
#define PG8_LDA(dst, b, h) do { _Pragma("unroll") for (int m = 0; m < 4; ++m) _Pragma("unroll") for (int k = 0; k < 2; ++k) dst[m][k] = *(const PG8_LAS bf16x8*)(lds + PG8_SA(b, h) + aoff + m * 2048 + k * 1024); } while (0)
#define PG8_LDB(dst, b, h) do { _Pragma("unroll") for (int n = 0; n < 2; ++n) _Pragma("unroll") for (int k = 0; k < 2; ++k) dst[n][k] = *(const PG8_LAS bf16x8*)(lds + PG8_SB(b, h) + boff + n * 2048 + k * 1024); } while (0)
#define PG8_MMA(ai, bj, At, Bt) do { __builtin_amdgcn_s_setprio(1); _Pragma("unroll") for (int m = 0; m < 4; ++m) _Pragma("unroll") for (int n = 0; n < 2; ++n) _Pragma("unroll") for (int k = 0; k < 2; ++k) \
        acc[ai][bj][m][n] = __builtin_amdgcn_mfma_f32_16x16x32_bf16(Bt[n][k], At[m][k], acc[ai][bj][m][n], 0, 0, 0); __builtin_amdgcn_s_setprio(0); } while (0)
#define PG8_WAIT_V(n) asm volatile("s_waitcnt vmcnt(" #n ")" ::: "memory")
#define PG8_WAIT_L(n) asm volatile("s_waitcnt lgkmcnt(" #n ")" ::: "memory")
#define PG8_BAR __builtin_amdgcn_s_barrier()
#define PG8_SCHED __builtin_amdgcn_sched_barrier(0)
    Unit cur, nxt; int ui = 0;
    if (!S.next(0, cur)) return;
    f32x4 acc[2][2][4][2];
#pragma unroll
    for (int a = 0; a < 2; ++a)
#pragma unroll
        for (int b = 0; b < 2; ++b)
#pragma unroll
            for (int m = 0; m < 4; ++m)
#pragma unroll
                for (int n = 0; n < 2; ++n) acc[a][b][m][n] = (f32x4){0.f, 0.f, 0.f, 0.f};
    bf16x8 At[4][2], B0[2][2], B1[2][2];
    const char* cA = (const char*)g.A + (size_t)cur.pm * tstep; const char* cB = (const char*)g.Bt + (size_t)cur.pn * tstep;
    S.a_ready(cur);
    if constexpr (SP2) {
        PG8_STAGE(PG8_SB(0, 0), cB, voffB); PG8_STAGE(PG8_SB(0, 1), cB + hstep, voffB); PG8_STAGE(PG8_SA(0, 0), cA, voffA); PG8_STAGE(PG8_SA(0, 1), cA + hstep, voffA);
        if (wr == 1) PG8_BAR;
        PG8_WAIT_V(2); PG8_BAR;
        PG8_STAGE(PG8_SB(1, 0), cB + kstep, voffB); PG8_STAGE(PG8_SA(1, 0), cA + kstep, voffA); PG8_STAGE(PG8_SB(1, 1), cB + hstep + kstep, voffB);
        PG8_WAIT_V(6); PG8_BAR;
    } else {
        PG8_STAGE(PG8_SB(0, 0), cB, voffB); PG8_STAGE(PG8_SA(0, 0), cA, voffA); PG8_STAGE(PG8_SB(0, 1), cB + hstep, voffB); PG8_STAGE(PG8_SA(0, 1), cA + hstep, voffA);
        if (wr == 1) PG8_BAR;
        PG8_WAIT_V(4); PG8_BAR;
        PG8_STAGE(PG8_SB(1, 0), cB + kstep, voffB); PG8_STAGE(PG8_SA(1, 0), cA + kstep, voffA); PG8_STAGE(PG8_SB(1, 1), cB + hstep + kstep, voffB);
        PG8_WAIT_V(6); PG8_BAR;
    }
    for (;;) {
        const bool has_next = S.next(ui + 1, nxt);
        const char* nA = has_next ? (const char*)g.A + (size_t)nxt.pm * tstep : cA; const char* nB = has_next ? (const char*)g.Bt + (size_t)nxt.pn * tstep : cB;
        for (int t = 0; t < nt; t += 2) {
            const bool last = (t == nt - 2);
            const char* a1 = cA + (size_t)(t + 1) * kstep;
            const char* a2 = last ? nA : cA + (size_t)(t + 2) * kstep; const char* b2 = last ? nB : cB + (size_t)(t + 2) * kstep;
            const char* a3 = a2 + kstep; const char* b3 = b2 + kstep;
            if (last && has_next) S.a_ready(nxt);
            if constexpr (SP2) {
            PG8_LDB(B0, 0, 0); PG8_LDB(B1, 0, 1); PG8_SCHED; PG8_LDA(At, 0, 0); PG8_STAGE(PG8_SA(1, 1), a1 + hstep, voffA);
            PG8_WAIT_V(8); PG8_WAIT_L(0); PG8_BAR; PG8_MMA(0, 0, At, B0); PG8_MMA(0, 1, At, B1); PG8_BAR; PG8_SCHED;
            PG8_LDA(At, 0, 1); PG8_STAGE(PG8_SB(0, 0), b2, voffB); PG8_STAGE(PG8_SB(0, 1), b2 + hstep, voffB); PG8_STAGE(PG8_SA(0, 0), a2, voffA);
            PG8_WAIT_V(8); PG8_WAIT_L(0); PG8_BAR; PG8_MMA(1, 0, At, B0); PG8_MMA(1, 1, At, B1); PG8_BAR; PG8_SCHED;
            PG8_LDB(B0, 1, 0); PG8_LDB(B1, 1, 1); PG8_SCHED; PG8_LDA(At, 1, 0); PG8_STAGE(PG8_SA(0, 1), a2 + hstep, voffA);
            PG8_WAIT_V(8); PG8_WAIT_L(0); PG8_BAR; PG8_MMA(0, 0, At, B0); PG8_MMA(0, 1, At, B1); PG8_BAR; PG8_SCHED;
            PG8_LDA(At, 1, 1); PG8_STAGE(PG8_SB(1, 0), b3, voffB); PG8_STAGE(PG8_SB(1, 1), b3 + hstep, voffB); PG8_STAGE(PG8_SA(1, 0), a3, voffA);
            PG8_WAIT_V(8); PG8_WAIT_L(0); PG8_BAR; PG8_MMA(1, 0, At, B0); PG8_MMA(1, 1, At, B1); PG8_BAR; PG8_SCHED;
            } else {
            PG8_LDB(B0, 0, 0); PG8_SCHED; PG8_LDA(At, 0, 0); PG8_STAGE(PG8_SA(1, 1), a1 + hstep, voffA);
            PG8_WAIT_L(8); PG8_BAR; PG8_WAIT_L(0); PG8_MMA(0, 0, At, B0); PG8_BAR; PG8_SCHED;
            PG8_LDB(B1, 0, 1); PG8_STAGE(PG8_SB(0, 0), b2, voffB);
            PG8_BAR; PG8_WAIT_L(0); PG8_MMA(0, 1, At, B1); PG8_BAR;
            PG8_LDA(At, 0, 1); PG8_STAGE(PG8_SA(0, 0), a2, voffA);
            PG8_BAR; PG8_WAIT_L(0); PG8_MMA(1, 0, At, B0); PG8_BAR; PG8_SCHED;
            PG8_STAGE(PG8_SB(0, 1), b2 + hstep, voffB);
            PG8_WAIT_V(6); PG8_BAR; PG8_MMA(1, 1, At, B1); PG8_BAR;
            PG8_LDB(B0, 1, 0); PG8_SCHED; PG8_LDA(At, 1, 0); PG8_STAGE(PG8_SA(0, 1), a2 + hstep, voffA);
            PG8_WAIT_L(8); PG8_BAR; PG8_WAIT_L(0); PG8_MMA(0, 0, At, B0); PG8_BAR; PG8_SCHED;
            PG8_LDB(B1, 1, 1); PG8_STAGE(PG8_SB(1, 0), b3, voffB);
            PG8_BAR; PG8_WAIT_L(0); PG8_MMA(0, 1, At, B1); PG8_BAR;
            PG8_LDA(At, 1, 1); PG8_STAGE(PG8_SA(1, 0), a3, voffA);
            PG8_BAR; PG8_WAIT_L(0); PG8_MMA(1, 0, At, B0); PG8_BAR; PG8_SCHED;
            PG8_STAGE(PG8_SB(1, 1), b3 + hstep, voffB);
            PG8_WAIT_V(6); PG8_BAR; PG8_MMA(1, 1, At, B1); PG8_BAR;
            }
        }
        if constexpr (ALIGN_EPI) { if (wr == 0) PG8_BAR; }
        if constexpr (!Epi::AFTER_DRAIN) { E(acc, cur, wr, wc, fr, fq); S.done(cur); }
        if (!has_next) break;
#pragma unroll
        for (int a = 0; a < 2; ++a)
#pragma unroll
            for (int b = 0; b < 2; ++b)
#pragma unroll
                for (int m = 0; m < 4; ++m)
#pragma unroll
                    for (int n = 0; n < 2; ++n) acc[a][b][m][n] = (f32x4){0.f, 0.f, 0.f, 0.f};
        cur = nxt; cA = nA; cB = nB; ++ui;
        if constexpr (ALIGN_EPI) { if (wr == 1) PG8_BAR; }
    }
    PG8_WAIT_V(0);
    if constexpr (!ALIGN_EPI) { if (wr == 0) PG8_BAR; }
    PG8_BAR;
    if constexpr (Epi::AFTER_DRAIN) { E.fused(acc, cur, wr, wc, fr, fq, lds, wid, lane); S.done(cur); }
#undef PG8_SA
#undef PG8_SB
#undef PG8_STAGE
#undef PG8_LDA
#undef PG8_LDB
#undef PG8_MMA
#undef PG8_WAIT_V
#undef PG8_WAIT_L
#undef PG8_BAR
#undef PG8_SCHED
}
}
#define GAS __attribute__((address_space(1)))
#define LAS __attribute__((address_space(3)))
typedef unsigned short bf16;
typedef unsigned v4u __attribute__((ext_vector_type(4)));
typedef float f32x4 __attribute__((ext_vector_type(4)));
typedef short bf16x8 __attribute__((ext_vector_type(8)));
typedef GAS unsigned gu32;
typedef GAS unsigned long long gu64;
#define RLX_AGENT __ATOMIC_RELAXED, __HIP_MEMORY_SCOPE_AGENT
#define LDS_WAIT() asm volatile("s_waitcnt lgkmcnt(0)" ::: "memory")
#define VM_WAIT() asm volatile("s_waitcnt vmcnt(0)" ::: "memory")
__device__ __forceinline__ unsigned long long rt() { return __builtin_amdgcn_s_memrealtime(); }
__device__ __forceinline__ unsigned f2bf(float f) { unsigned u = __builtin_bit_cast(unsigned, f); return (u + 0x7fffu + ((u >> 16) & 1u)) >> 16; }
__device__ __forceinline__ unsigned pk2(float lo, float hi) { return f2bf(lo) | (f2bf(hi) << 16); }

#define XB_TMO      128
#define XB_XCNT(j)  (256  + 64 * (j))
#define XB_XSUB(j)  (1280 + 64 * (j))
#define XB_XGEN(j)  (2304 + 64 * (j))
#define XB_TOP      3328
#define XB_TOPGEN   3392
#define XCD_BAR_WORDS 3456
#define XB_SPIN_CAP (1u << 18)

__device__ __forceinline__ unsigned xb_ld(unsigned* p)              { return __hip_atomic_load(p, __ATOMIC_RELAXED, __HIP_MEMORY_SCOPE_AGENT); }
__device__ __forceinline__ unsigned xb_add(unsigned* p, unsigned v) { return __hip_atomic_fetch_add(p, v, __ATOMIC_RELAXED, __HIP_MEMORY_SCOPE_AGENT); }
__device__ __forceinline__ unsigned xb_xcc_id() { return (unsigned)__builtin_amdgcn_s_getreg((3 << 11) | 20) & 0xFu; }
#define XB_SPIN(cond, bar) do { unsigned _sp = 0; while (cond) { __builtin_amdgcn_s_sleep(1); \
    if ((++_sp & 255u) == 0u) { if (xb_ld(&(bar)[XB_TMO])) break; if (_sp > XB_SPIN_CAP) { atomicAdd(&(bar)[XB_TMO], 1u); break; } } } } while (0)

struct XcdBarrier {
    unsigned* bar; unsigned x;
    volatile LAS unsigned* st;
};

__device__ __forceinline__ XcdBarrier xcd_barrier_post(unsigned* bar, volatile LAS unsigned* st) {
    XcdBarrier b; b.bar = bar; b.x = xb_xcc_id(); b.st = st;
    if (threadIdx.x == 0) (void)xb_add(&bar[XB_XCNT(b.x)], 1u);
    return b;
}
__device__ __forceinline__ void xcd_barrier_complete(unsigned* bar, unsigned x, unsigned& nloc, unsigned& nx) {
    const unsigned G = gridDim.x * gridDim.y * gridDim.z;
    unsigned sum, cnt, mine, sp = 0u;
    for (;;) {
        sum = 0u; cnt = 0u; mine = 0u;
#pragma unroll
        for (unsigned j = 0; j < 16; ++j) { const unsigned c = xb_ld(&bar[XB_XCNT(j)]); sum += c; cnt += (c > 0u) ? 1u : 0u; mine = (j == x) ? c : mine; }
        if (sum == G) break;
        __builtin_amdgcn_s_sleep(1);
        if ((++sp & 255u) == 0u) { if (xb_ld(&bar[XB_TMO])) break; if (sp > XB_SPIN_CAP) { atomicAdd(&bar[XB_TMO], 1u); break; } }
    }
    nloc = mine > 0u ? mine : 1u; nx = cnt > 0u ? cnt : 1u;
}

__device__ __forceinline__ void xcd_barrier(const XcdBarrier& b) {
    asm volatile("s_waitcnt vmcnt(0)" ::: "memory");
    __syncthreads();
    if (threadIdx.x == 0) {
        unsigned* bar = b.bar;
        __builtin_amdgcn_s_waitcnt(0);
        unsigned nloc = b.st[0], nx = b.st[1];
        if (nloc == 0u) { xcd_barrier_complete(bar, b.x, nloc, nx); b.st[0] = nloc; b.st[1] = nx; }
        const unsigned old = xb_add(&bar[XB_XSUB(b.x)], 1u);
        const unsigned gen = old / nloc;
        if (old + 1u == (gen + 1u) * nloc) {
            __builtin_amdgcn_fence(__ATOMIC_RELEASE, "agent");
            asm volatile("s_waitcnt vmcnt(0)" ::: "memory");
            const unsigned og = xb_add(&bar[XB_TOP], 1u);
            const unsigned tg = og / nx;
            if (og + 1u == (tg + 1u) * nx) xb_add(&bar[XB_TOPGEN], 1u);
            else XB_SPIN(xb_ld(&bar[XB_TOPGEN]) == tg, bar);
            __builtin_amdgcn_fence(__ATOMIC_ACQUIRE, "agent");
            xb_add(&bar[XB_XGEN(b.x)], 1u);
            asm volatile("s_waitcnt vmcnt(0)" ::: "memory");
        } else {
            XB_SPIN(xb_ld(&bar[XB_XGEN(b.x)]) == gen, bar);
            __builtin_amdgcn_fence(__ATOMIC_ACQUIRE, "agent");
            asm volatile("s_waitcnt vmcnt(0)" ::: "memory");
        }
    }
    __syncthreads();
}

#define DI __device__ __forceinline__
typedef float f32x16 __attribute__((ext_vector_type(16)));
typedef short s16x4 __attribute__((ext_vector_type(4)));
typedef unsigned u32x2 __attribute__((ext_vector_type(2)));
typedef float f32x2_t __attribute__((ext_vector_type(2)));
typedef __bf16 bf16x2_t __attribute__((ext_vector_type(2)));
#define MFMA32(a, b, c) __builtin_amdgcn_mfma_f32_32x32x16_bf16((a), (b), (c), 0, 0, 0)
#define MFMA16(a, b, c) __builtin_amdgcn_mfma_f32_16x16x32_bf16((a), (b), (c), 0, 0, 0)

constexpr int BATCH = 8, T = 4096, D = 1024, H = 8, HD = 128, FF = 4096;
constexpr int M = BATCH * T;
constexpr int NDN = 4 * D + 2 * H;
constexpr int NDN_PAD = 4352;
constexpr int NMB = 3 * D;
constexpr int CL = 64, NCH = T / CL;
constexpr float RMS_EPS = 1e-6f;
constexpr int NWAVES = 8;
constexpr float LOG2E = 1.4426950408889634f;
constexpr float QSCALE = 0.08838834764831845f * LOG2E;

constexpr size_t MiB = 1u << 20;
constexpr size_t WS_CTL = 0, CTL_ZERO_BYTES = 1 * MiB;
constexpr size_t WS_BETA = 1 * MiB, WS_G = 2 * MiB, WS_KPART = 3 * MiB;
constexpr size_t WS_SSQ = 4 * MiB;
constexpr size_t WS_GTOT = 12 * MiB;
constexpr size_t WS_W = 13 * MiB;
constexpr size_t WS_WDNIN = WS_W, WS_WDNOUT = WS_WDNIN + (size_t)NDN_PAD * D * 2, WS_WUP0 = WS_WDNOUT + (size_t)D * D * 2, WS_WDOWN0 = WS_WUP0 + (size_t)FF * D * 2,
                 WS_WMBIN = WS_WDOWN0 + (size_t)FF * D * 2, WS_WMBOUT = WS_WMBIN + (size_t)NMB * D * 2, WS_WUP1 = WS_WMBOUT + (size_t)D * D * 2, WS_WDOWN1 = WS_WUP1 + (size_t)FF * D * 2,
                 WS_WEND = WS_WDOWN1 + (size_t)FF * D * 2;
static_assert(WS_WEND <= 64 * MiB, "weights fit below 64 MiB");
constexpr size_t WS_Q0 = 64 * MiB;
constexpr size_t WS_K0 = 128 * MiB;
constexpr size_t WS_CH = 192 * MiB;
constexpr size_t WS_END = 480 * MiB;
constexpr size_t CH_BYTES = 73728;
constexpr size_t CH_W = 0, CH_U = 16384, CH_QD = 32768, CH_KD = 49152, CH_AT = 65536;
static_assert(WS_CH + (size_t)BATCH * H * NCH * CH_BYTES <= WS_END, "chunk operand region");

constexpr int CW_TMO = 0, CW_CODE = 1, CW_MAPBAD = 2, CW_ATTQ = 64, CW_BAR = 4096, CW_FLAG = 16384;

constexpr int LDS_BYTES = 163840;
constexpr int MISC_OFF = LDS_BYTES - 512;

#define LBAR() do { asm volatile("s_waitcnt lgkmcnt(0)" ::: "memory"); __builtin_amdgcn_s_barrier(); asm volatile("" ::: "memory"); } while (0)
DI float bf2f(unsigned short b) { return __uint_as_float((unsigned)b << 16); }
DI unsigned cvtpk(float lo, float hi) { f32x2_t v = {lo, hi}; bf16x2_t b = __builtin_convertvector(v, bf16x2_t); return __builtin_bit_cast(unsigned, b); }
DI float wave_sum(float v) {
#pragma unroll
    for (int o = 1; o < 64; o <<= 1) v += __shfl_xor(v, o);
    return v;
}
DI void swap32_self(float v, float& a, float& b) { a = v; b = v; asm volatile("s_nop 1\n\tv_permlane32_swap_b32 %0, %1\n\ts_nop 0" : "+v"(a), "+v"(b)); }
DI void swap16_self(float v, float& a, float& b) { a = v; b = v; asm volatile("s_nop 1\n\tv_permlane16_swap_b32 %0, %1\n\ts_nop 0" : "+v"(a), "+v"(b)); }
DI float sum_x32(float v) { float a, b; swap32_self(v, a, b); return a + b; }
DI float sum_x16(float v) { float a, b; swap16_self(v, a, b); return a + b; }
DI float max_x32(float v) { float a, b; swap32_self(v, a, b); return fmaxf(a, b); }
DI float get_x32(float v, int hi) { float a, b; swap32_self(v, a, b); return hi ? a : b; }
DI float sigmoidf_(float x) { return __builtin_amdgcn_rcpf(1.f + __builtin_amdgcn_exp2f(-LOG2E * x)); }
DI float siluf_(float x) { return x * __builtin_amdgcn_rcpf(1.f + __builtin_amdgcn_exp2f(-LOG2E * x)); }
DI unsigned short f2bfq(float x) { return (unsigned short)cvtpk(x, 0.f); }
DI float softplusf_(float x) { return fmaxf(x, 0.f) + log1pf(__expf(-fabsf(x))); }

struct Frame {
    LAS unsigned char* lds;
    volatile LAS unsigned* MISC;
    gu32* ctl;
    int tid, lane, wave;
    int vcu, G, var;
    bool fast;
    const float *x, *mix_g, *mlp_g, *dn_w_in, *dn_conv_w, *dn_a_log, *dn_dt_bias, *dn_out_g, *dn_w_out, *mb_w_in, *mb_w_out, *w_up, *w_down, *final_g;
    float* out; unsigned char* ws;
};

struct EpiDnIn {
    static constexpr bool PERM = true, AFTER_DRAIN = false;
    bf16 *QK0, *ZV0;
    __device__ __forceinline__ void operator()(const pg8::f32x4 (&acc)[2][2][4][2], const pg8::Unit& u, int wr, int wc, int fr, int fq) const {
        const int row0 = u.pm * 256 + wr * 64 + fr;
        {
            const int ts = u.pn >> 2; bf16* base = (ts < 2) ? QK0 + (size_t)ts * M * D : ZV0 + (size_t)(3 - ts) * M * D;
            const int col0 = (u.pn & 3) * 256 + wc * 32 + 8 * fq;
#pragma unroll
            for (int ai = 0; ai < 2; ++ai)
#pragma unroll
                for (int m = 0; m < 4; ++m) { bf16* rowp = base + (size_t)(row0 + ai * 128 + m * 16) * D + col0;
#pragma unroll
                    for (int bj = 0; bj < 2; ++bj) { const pg8::f32x4 v0 = acc[ai][bj][m][0], v1 = acc[ai][bj][m][1];
                        v4u w; w.x = cvtpk(v0[0], v0[1]); w.y = cvtpk(v0[2], v0[3]); w.z = cvtpk(v1[0], v1[1]); w.w = cvtpk(v1[2], v1[3]);
                        *(v4u*)(rowp + bj * 128) = w; } }
        }
    }
};
struct EpiResid {
    static constexpr bool PERM = true, AFTER_DRAIN = false;
    const float* resid32; bf16* xb; float* ssq;
    __device__ __forceinline__ void operator()(const pg8::f32x4 (&acc)[2][2][4][2], const pg8::Unit& u, int wr, int wc, int fr, int fq) const {
        const int row0 = u.pm * 256 + wr * 64 + fr, col0 = u.pn * 256 + wc * 32 + 8 * fq;
        if (resid32) {
#pragma unroll
            for (int ai = 0; ai < 2; ++ai) { f32x4 ra[4][2][2];
#pragma unroll
                for (int m = 0; m < 4; ++m)
#pragma unroll
                    for (int bj = 0; bj < 2; ++bj) { const size_t o2 = (size_t)(row0 + ai * 128 + m * 16) * D + col0 + bj * 128; ra[m][bj][0] = *(const f32x4*)(resid32 + o2); ra[m][bj][1] = *(const f32x4*)(resid32 + o2 + 4); }
#pragma unroll
                for (int m = 0; m < 4; ++m) { const int row = row0 + ai * 128 + m * 16; const size_t off = (size_t)row * D + col0; float ss = 0.f;
#pragma unroll
                    for (int bj = 0; bj < 2; ++bj) { const size_t o2 = off + bj * 128; float r[8];
                        r[0] = ra[m][bj][0][0]; r[1] = ra[m][bj][0][1]; r[2] = ra[m][bj][0][2]; r[3] = ra[m][bj][0][3]; r[4] = ra[m][bj][1][0]; r[5] = ra[m][bj][1][1]; r[6] = ra[m][bj][1][2]; r[7] = ra[m][bj][1][3];
                        const pg8::f32x4 v0 = acc[ai][bj][m][0], v1 = acc[ai][bj][m][1];
                        r[0] += v0[0]; r[1] += v0[1]; r[2] += v0[2]; r[3] += v0[3]; r[4] += v1[0]; r[5] += v1[1]; r[6] += v1[2]; r[7] += v1[3];
                        v4u w; w.x = cvtpk(r[0], r[1]); w.y = cvtpk(r[2], r[3]); w.z = cvtpk(r[4], r[5]); w.w = cvtpk(r[6], r[7]); *(v4u*)(xb + o2) = w;
                        ss += ((r[0] * r[0] + r[1] * r[1]) + (r[2] * r[2] + r[3] * r[3])) + ((r[4] * r[4] + r[5] * r[5]) + (r[6] * r[6] + r[7] * r[7])); }
                    ss += __shfl_xor(ss, 16); ss += __shfl_xor(ss, 32);
                    if (fq == 0) ssq[(size_t)row * 16 + u.pn * 4 + wc] = ss; } }
        } else {
#pragma unroll
            for (int ai = 0; ai < 2; ++ai) { v4u qa[4][2];
#pragma unroll
                for (int m = 0; m < 4; ++m)
#pragma unroll
                    for (int bj = 0; bj < 2; ++bj) qa[m][bj] = *(const v4u*)(xb + (size_t)(row0 + ai * 128 + m * 16) * D + col0 + bj * 128);
#pragma unroll
                for (int m = 0; m < 4; ++m) { const int row = row0 + ai * 128 + m * 16; const size_t off = (size_t)row * D + col0; float ss = 0.f;
#pragma unroll
                    for (int bj = 0; bj < 2; ++bj) { const size_t o2 = off + bj * 128; float r[8]; const v4u q = qa[m][bj];
                        r[0] = __uint_as_float(q.x << 16); r[1] = __uint_as_float(q.x & 0xffff0000u); r[2] = __uint_as_float(q.y << 16); r[3] = __uint_as_float(q.y & 0xffff0000u);
                        r[4] = __uint_as_float(q.z << 16); r[5] = __uint_as_float(q.z & 0xffff0000u); r[6] = __uint_as_float(q.w << 16); r[7] = __uint_as_float(q.w & 0xffff0000u);
                        const pg8::f32x4 v0 = acc[ai][bj][m][0], v1 = acc[ai][bj][m][1];
                        r[0] += v0[0]; r[1] += v0[1]; r[2] += v0[2]; r[3] += v0[3]; r[4] += v1[0]; r[5] += v1[1]; r[6] += v1[2]; r[7] += v1[3];
                        v4u w; w.x = cvtpk(r[0], r[1]); w.y = cvtpk(r[2], r[3]); w.z = cvtpk(r[4], r[5]); w.w = cvtpk(r[6], r[7]); *(v4u*)(xb + o2) = w;
                        ss += ((r[0] * r[0] + r[1] * r[1]) + (r[2] * r[2] + r[3] * r[3])) + ((r[4] * r[4] + r[5] * r[5]) + (r[6] * r[6] + r[7] * r[7])); }
                    ss = sum_x16(ss); ss = sum_x32(ss);
                    if (fq == 0) ssq[(size_t)row * 16 + u.pn * 4 + wc] = ss; } }
        }
    }
};
DI float rstd_from_ssq(const float* ssq, int row) {
    const f32x4 a = *(const f32x4*)(ssq + (size_t)row * 16), b = *(const f32x4*)(ssq + (size_t)row * 16 + 4), c = *(const f32x4*)(ssq + (size_t)row * 16 + 8), d = *(const f32x4*)(ssq + (size_t)row * 16 + 12);
    const float s = ((a[0] + a[1]) + (a[2] + a[3])) + ((b[0] + b[1]) + (b[2] + b[3])) + ((c[0] + c[1]) + (c[2] + c[3])) + ((d[0] + d[1]) + (d[2] + d[3]));
    return rsqrtf(s * (1.f / D) + RMS_EPS);
}
struct EpiUp {
    static constexpr bool PERM = true, AFTER_DRAIN = false;
    bf16* hid; const LAS float* rtab;
    __device__ __forceinline__ void operator()(const pg8::f32x4 (&acc)[2][2][4][2], const pg8::Unit& u, int wr, int wc, int fr, int fq) const {
        const int row0 = u.pm * 256 + wr * 64 + fr, col0 = u.pn * 256 + wc * 32 + 8 * fq;
#pragma unroll
        for (int ai = 0; ai < 2; ++ai)
#pragma unroll
            for (int m = 0; m < 4; ++m) { const int row = row0 + ai * 128 + m * 16; const float rs = rtab[u.ui * 256 + ai * 128 + wr * 64 + m * 16 + fr]; bf16* rowp = hid + (size_t)row * FF + col0;
#pragma unroll
                for (int bj = 0; bj < 2; ++bj) { pg8::f32x4 v0 = acc[ai][bj][m][0] * rs, v1 = acc[ai][bj][m][1] * rs;
#pragma unroll
                    for (int i = 0; i < 4; ++i) { const float a = fmaxf(v0[i], 0.f), b = fmaxf(v1[i], 0.f); v0[i] = a * a; v1[i] = b * b; }
                    v4u w; w.x = cvtpk(v0[0], v0[1]); w.y = cvtpk(v0[2], v0[3]); w.z = cvtpk(v1[0], v1[1]); w.w = cvtpk(v1[2], v1[3]);
                    *(v4u*)(rowp + bj * 128) = w; } }
    }
};
struct EpiMbIn {
    static constexpr bool PERM = true, AFTER_DRAIN = false;
    bf16 *QKV1; float* kpart; const LAS float* rtab; float* kn2;
    __device__ __forceinline__ void operator()(const pg8::f32x4 (&acc)[2][2][4][2], const pg8::Unit& u, int wr, int wc, int fr, int fq) const {
        const int row0 = u.pm * 256 + wr * 64 + fr; const int ts = u.pn >> 2; bf16* base = QKV1 + (size_t)ts * M * D;
        const int col0 = (u.pn & 3) * 256 + wc * 32 + 8 * fq; const float sc = ts == 0 ? QSCALE : 1.f;
        float cs[2][8];
#pragma unroll
        for (int bj = 0; bj < 2; ++bj)
#pragma unroll
            for (int i = 0; i < 8; ++i) cs[bj][i] = 0.f;
#pragma unroll
        for (int ai = 0; ai < 2; ++ai)
#pragma unroll
            for (int m = 0; m < 4; ++m) { const int row = row0 + ai * 128 + m * 16; const float rs = rtab[u.ui * 256 + ai * 128 + wr * 64 + m * 16 + fr] * sc; bf16* rowp = base + (size_t)row * D + col0;
#pragma unroll
                for (int bj = 0; bj < 2; ++bj) { const pg8::f32x4 v0 = acc[ai][bj][m][0] * rs, v1 = acc[ai][bj][m][1] * rs;
#pragma unroll
                    for (int i = 0; i < 4; ++i) { cs[bj][i] += v0[i]; cs[bj][4 + i] += v1[i]; }
                    v4u w; w.x = cvtpk(v0[0], v0[1]); w.y = cvtpk(v0[2], v0[3]); w.z = cvtpk(v1[0], v1[1]); w.w = cvtpk(v1[2], v1[3]);
                    *(v4u*)(rowp + bj * 128) = w;
                    if (ts == 1) { float ss = ((v0[0] * v0[0] + v0[1] * v0[1]) + (v0[2] * v0[2] + v0[3] * v0[3])) + ((v1[0] * v1[0] + v1[1] * v1[1]) + (v1[2] * v1[2] + v1[3] * v1[3]));
                        ss = sum_x16(ss); ss = sum_x32(ss);
                        if (fq == 0) atomicAdd(kn2 + (size_t)row * 8 + 2 * (u.pn & 3) + bj, ss); } } }
        if (ts == 1) {
#pragma unroll
            for (int bj = 0; bj < 2; ++bj)
#pragma unroll
                for (int i = 0; i < 8; ++i) { float s = cs[bj][i];
#define MB_ROR_ADD(n_) s += __builtin_bit_cast(float, __builtin_amdgcn_update_dpp(0, __builtin_bit_cast(int, s), 0x120 + (n_), 0xF, 0xF, false))
                    MB_ROR_ADD(8); MB_ROR_ADD(4); MB_ROR_ADD(2); MB_ROR_ADD(1);
#undef MB_ROR_ADD
                    cs[bj][i] = s; }
            if (fr == 0) { float* dst = kpart + (size_t)(u.pm * 2 + wr) * D + col0;
#pragma unroll
                for (int bj = 0; bj < 2; ++bj) { *(f32x4*)(dst + bj * 128) = (f32x4){cs[bj][0], cs[bj][1], cs[bj][2], cs[bj][3]}; *(f32x4*)(dst + bj * 128 + 4) = (f32x4){cs[bj][4], cs[bj][5], cs[bj][6], cs[bj][7]}; } }
        }
    }
};

DI void p0_transpose_item(const float* W, int ldw, int K, const float* gk, bf16* WT, LAS float* scr, int item, int nblk, int lane) {
    const int kb = item / nblk, nb = item % nblk, k0 = 64 * kb, n0 = 32 * nb;
#pragma unroll 8
    for (int i = 0; i < 32; ++i) { const int kk = 2 * i + (lane >> 5); scr[kk * 33 + (lane & 31)] = W[(size_t)(k0 + kk) * ldw + n0 + (lane & 31)]; }
    LDS_WAIT(); asm volatile("" ::: "memory");
    const int c = lane & 7;
    f32x4 ga = {1.f, 1.f, 1.f, 1.f}, gb = ga;
    if (gk) { ga = *(const f32x4*)(gk + k0 + 8 * c); gb = *(const f32x4*)(gk + k0 + 8 * c + 4); }
#pragma unroll
    for (int j = 0; j < 4; ++j) { const int n = (lane >> 3) + 8 * j; const LAS float* s = scr + (8 * c) * 33 + n;
        v4u o; o.x = cvtpk(s[0 * 33] * ga[0], s[1 * 33] * ga[1]); o.y = cvtpk(s[2 * 33] * ga[2], s[3 * 33] * ga[3]); o.z = cvtpk(s[4 * 33] * gb[0], s[5 * 33] * gb[1]); o.w = cvtpk(s[6 * 33] * gb[2], s[7 * 33] * gb[3]);
        *(GAS v4u*)(WT + (size_t)(n0 + n) * K + k0 + 8 * c) = o; }
    LDS_WAIT(); asm volatile("" ::: "memory");
}
DI void rms_row_to_bf16(const float* xrow, const f32x4 (&gg4)[4], bf16* orow, int lane) {
    const GAS f32x4* xr = (const GAS f32x4*)xrow + lane;
    f32x4 v[4]; float s = 0.f;
#pragma unroll
    for (int j = 0; j < 4; ++j) { v[j] = xr[64 * j]; s += (v[j].x * v[j].x + v[j].y * v[j].y) + (v[j].z * v[j].z + v[j].w * v[j].w); }
    const float rstd = rsqrtf(wave_sum(s) * (1.f / D) + RMS_EPS);
    GAS unsigned long long* o8 = (GAS unsigned long long*)orow + lane;
#pragma unroll
    for (int j = 0; j < 4; ++j) { const f32x4 gg = gg4[j]; o8[64 * j] = (unsigned long long)cvtpk(v[j].x * rstd * gg.x, v[j].y * rstd * gg.y) | ((unsigned long long)cvtpk(v[j].z * rstd * gg.z, v[j].w * rstd * gg.w) << 32); }
}
DI void p0_prologue(Frame& F) {
    LAS float* scr = (LAS float*)(F.lds + F.wave * 16384);
    const int gw = F.vcu * NWAVES + F.wave, NGW = F.G * NWAVES;
    bf16* const wdnin = (bf16*)(F.ws + WS_WDNIN);
    constexpr int I_DNIN = (D / 64) * (4096 / 32), I_SQ = (D / 64) * (D / 32), I_UP = (D / 64) * (FF / 32), I_DOWN = (FF / 64) * (D / 32);
    constexpr int NITEMS = I_DNIN + I_SQ + I_UP + I_DOWN;
    for (int it = gw; it < NITEMS; it += NGW) {
        int r = it;
        if (r < I_DNIN) { p0_transpose_item(F.dn_w_in, NDN, D, nullptr, wdnin, scr, r, 4096 / 32, F.lane); continue; } r -= I_DNIN;
        if (r < I_SQ) { p0_transpose_item(F.dn_w_out, D, D, nullptr, (bf16*)(F.ws + WS_WDNOUT), scr, r, D / 32, F.lane); continue; } r -= I_SQ;
        if (r < I_UP) { p0_transpose_item(F.w_up, FF, D, F.mlp_g, (bf16*)(F.ws + WS_WUP0), scr, r, FF / 32, F.lane); continue; } r -= I_UP;
        p0_transpose_item(F.w_down, D, FF, nullptr, (bf16*)(F.ws + WS_WDOWN0), scr, r, D / 32, F.lane);
    }
    const int gt = F.vcu * (NWAVES * 64) + F.tid, NGT = F.G * NWAVES * 64;
    for (int e = gt; e < 16 * D; e += NGT) { const int n = e >> 10, k = e & (D - 1); wdnin[(size_t)(4096 + n) * D + k] = (bf16)f2bf(F.dn_w_in[(size_t)k * NDN + 4096 + n]); }
    bf16* XN = (bf16*)(F.ws + WS_CH);
    f32x4 gg4[4];
#pragma unroll
    for (int j = 0; j < 4; ++j) gg4[j] = *((const GAS f32x4*)F.mix_g + F.lane + 64 * j);
#pragma unroll 2
    for (int m = gw; m < M; m += NGW) rms_row_to_bf16(F.x + (size_t)m * D, gg4, XN + (size_t)m * D, F.lane);
}
DI void p0b_layer1_weights(Frame& F, int w, int nw) {
    LAS float* scr = (LAS float*)(F.lds + F.wave * 16384);
    const int gw = w * NWAVES + F.wave, NGW = nw * NWAVES;
    constexpr int I_SQ = (D / 64) * (D / 32), I_UP = (D / 64) * (FF / 32), I_DOWN = (FF / 64) * (D / 32), I_MBIN = (D / 64) * (NMB / 32);
    constexpr int NITEMS = I_MBIN + I_SQ + I_UP + I_DOWN;
    for (int it = gw; it < NITEMS; it += NGW) {
        int r = it;
        if (r < I_MBIN) { p0_transpose_item(F.mb_w_in, NMB, D, F.mix_g + D, (bf16*)(F.ws + WS_WMBIN), scr, r, NMB / 32, F.lane); continue; } r -= I_MBIN;
        if (r < I_SQ) { p0_transpose_item(F.mb_w_out, D, D, nullptr, (bf16*)(F.ws + WS_WMBOUT), scr, r, D / 32, F.lane); continue; } r -= I_SQ;
        if (r < I_UP) { p0_transpose_item(F.w_up + (size_t)D * FF, FF, D, F.mlp_g + D, (bf16*)(F.ws + WS_WUP1), scr, r, FF / 32, F.lane); continue; } r -= I_UP;
        p0_transpose_item(F.w_down + (size_t)FF * D, D, FF, nullptr, (bf16*)(F.ws + WS_WDOWN1), scr, r, D / 32, F.lane);
    }
}
DI void p1_beta_g(Frame& F) {
    const int lane = F.lane, fr = lane & 15, fq = lane >> 4;
    const bf16* XN = (const bf16*)(F.ws + WS_CH); const bf16* W16 = (const bf16*)(F.ws + WS_WDNIN) + (size_t)4096 * D;
    float* beta = (float*)(F.ws + WS_BETA); float* g = (float*)(F.ws + WS_G);
    for (int rt = F.vcu * NWAVES + F.wave; rt < M / 16; rt += F.G * NWAVES) {
        const bf16* ap = XN + (size_t)(rt * 16 + fr) * D + 8 * fq; const bf16* bp = W16 + (size_t)fr * D + 8 * fq;
        f32x4 acc0 = {0.f, 0.f, 0.f, 0.f}, acc1 = {0.f, 0.f, 0.f, 0.f};
#pragma unroll 4
        for (int ks = 0; ks < 32; ks += 2) { const bf16x8 a0 = *(const bf16x8*)(ap + 32 * ks), b0 = *(const bf16x8*)(bp + 32 * ks), a1 = *(const bf16x8*)(ap + 32 * ks + 32), b1 = *(const bf16x8*)(bp + 32 * ks + 32);
            acc0 = MFMA16(a0, b0, acc0); acc1 = MFMA16(a1, b1, acc1); }
        const int n = fr; const float al = -__expf(F.dn_a_log[n & 7]), db = F.dn_dt_bias[n & 7];
#pragma unroll
        for (int rg = 0; rg < 4; ++rg) { const float v = acc0[rg] + acc1[rg]; const size_t row = (size_t)rt * 16 + 4 * fq + rg;
            if (n < 8) beta[row * 8 + n] = sigmoidf_(v); else g[row * 8 + (n - 8)] = al * softplusf_(v + db); }
    }
}
DI void p_final(Frame& F) {
    const int gw = F.vcu * NWAVES + F.wave, NGW = F.G * NWAVES; const float* ssq = (const float*)(F.ws + WS_SSQ + 3 * 2 * MiB); const bf16* xb = (const bf16*)(F.ws + WS_K0);
    f32x4 gg[4];
#pragma unroll
    for (int j = 0; j < 4; ++j) gg[j] = *((const GAS f32x4*)F.final_g + 2 * F.lane + (j & 1) + 128 * (j >> 1));
    for (int m = gw; m < M; m += 2 * NGW) {
        const int m1 = m + NGW; const bool two = m1 < M; const int mb = two ? m1 : m;
        f32x4 sp[2][4]; v4u q[2][2];
#pragma unroll
        for (int t = 0; t < 2; ++t) { const int mm = t ? mb : m;
#pragma unroll
            for (int k = 0; k < 4; ++k) sp[t][k] = *(const f32x4*)(ssq + (size_t)mm * 16 + 4 * k);
#pragma unroll
            for (int hf = 0; hf < 2; ++hf) q[t][hf] = *(const v4u*)(xb + (size_t)mm * D + 512 * hf + 8 * F.lane); }
#pragma unroll
        for (int t = 0; t < 2; ++t) { if (t == 1 && !two) break; const int mm = t ? m1 : m;
            const float ssum = ((sp[t][0][0] + sp[t][0][1]) + (sp[t][0][2] + sp[t][0][3])) + ((sp[t][1][0] + sp[t][1][1]) + (sp[t][1][2] + sp[t][1][3])) + ((sp[t][2][0] + sp[t][2][1]) + (sp[t][2][2] + sp[t][2][3])) + ((sp[t][3][0] + sp[t][3][1]) + (sp[t][3][2] + sp[t][3][3]));
            const float rs = rsqrtf(ssum * (1.f / D) + RMS_EPS);
#pragma unroll
            for (int hf = 0; hf < 2; ++hf) { const v4u qq = q[t][hf];
                f32x4 a = {__uint_as_float(qq.x << 16), __uint_as_float(qq.x & 0xffff0000u), __uint_as_float(qq.y << 16), __uint_as_float(qq.y & 0xffff0000u)};
                f32x4 c = {__uint_as_float(qq.z << 16), __uint_as_float(qq.z & 0xffff0000u), __uint_as_float(qq.w << 16), __uint_as_float(qq.w & 0xffff0000u)};
                a = a * rs; a = a * gg[2 * hf]; c = c * rs; c = c * gg[2 * hf + 1];
                GAS f32x4* op = (GAS f32x4*)(F.out + (size_t)mm * D + 512 * hf + 8 * F.lane); op[0] = a; op[1] = c; } }
    }
}
DI void stagger(int quarter_ticks) {
    const int g = ((int)blockIdx.x >> 3) & 3;
    if (g) { const unsigned long long t0 = __builtin_amdgcn_s_memrealtime(); const unsigned long long d = (unsigned long long)(g * quarter_ticks);
        while (__builtin_amdgcn_s_memrealtime() - t0 < d) __builtin_amdgcn_s_sleep(8); }
}
constexpr int RTAB_OFF = 131072;
template <class Sched> DI void fill_rtab(Frame& F, const Sched& S, const float* ssq) {
    LAS float* rtab = (LAS float*)(F.lds + RTAB_OFF);
    const int r = F.tid & 255, i0 = __builtin_amdgcn_readfirstlane(F.tid >> 8);
    f32x4 v[4][4]; bool ok[4];
#pragma unroll
    for (int j = 0; j < 4; ++j) { pg8::Unit u; ok[j] = S.next(i0 + 2 * j, u); const float* p = ssq + (size_t)((ok[j] ? u.pm : 0) * 256 + r) * 16;
#pragma unroll
        for (int q = 0; q < 4; ++q) v[j][q] = *(const f32x4*)(p + 4 * q); }
#pragma unroll
    for (int j = 0; j < 4; ++j) { float sum = 0.f;
#pragma unroll
        for (int q = 0; q < 4; ++q) sum += (v[j][q][0] + v[j][q][1]) + (v[j][q][2] + v[j][q][3]);
        if (ok[j]) rtab[(i0 + 2 * j) * 256 + r] = rsqrtf(sum * (1.f / D) + RMS_EPS); }
    __syncthreads();
}

namespace attn {
constexpr int KP = 136, VP = 160;
constexpr int LDS_K = 0, LDS_V = 2 * 64 * KP * 2, LDS_KM = LDS_K  , LDS_Q = LDS_V + 3 * 64 * VP * 2, LDS_END = LDS_Q + 8 * 8 * 1024;
static_assert(LDS_END <= MISC_OFF, "attention LDS");
constexpr float THR = 8.f;
typedef short v4i16_t __attribute__((ext_vector_type(4)));
DI s16x4 vtr(const LAS bf16* p) { return __builtin_bit_cast(s16x4, __builtin_amdgcn_ds_read_tr16_b64_v4i16((LAS v4i16_t*)p)); }
DI void attn_unit(int b, int h, int qb, const bf16* Q, const bf16* K, const bf16* V, const float* kpart, const float* kn2, bf16* O, LAS unsigned char* lds, int tid) {
    const int lane = tid & 63, wid = __builtin_amdgcn_readfirstlane(tid >> 6), r = lane & 31, hh = lane >> 5;
    const size_t rowbase = (size_t)b * T;
    LAS bf16* KM = (LAS bf16*)(lds + LDS_KM);
    for (int e = tid; e < 32 * 128; e += NWAVES * 64) { const int j = e >> 7, d = e & 127; float v = 0.f;
        if (j < qb) { const float* p = kpart + ((size_t)(b * 16 + j) * 2) * D + h * HD + d; v = (p[0] + p[D]) * (1.f / 256.f); }
        KM[j * KP + d] = f2bfq(v); }
    const bf16* qrow = Q + (rowbase + qb * 256 + wid * 32 + r) * D + h * HD + hh * 8;
    bf16x8 qf[8];
#pragma unroll
    for (int ks = 0; ks < 8; ++ks) qf[ks] = *(const bf16x8*)(qrow + ks * 16);
    LAS bf16* Qs = (LAS bf16*)(lds + LDS_Q) + wid * 4096 + lane * 8;
#pragma unroll
    for (int ks = 0; ks < 8; ++ks) *(LAS bf16x8*)(Qs + ks * 512) = qf[ks];
    { float q2 = 0.f;
#pragma unroll
      for (int ks = 0; ks < 8; ++ks)
#pragma unroll
          for (int e = 0; e < 8; ++e) { const float v = bf2f((unsigned short)qf[ks][e]); q2 += v * v; }
      q2 = sum_x32(q2);
      float k2 = 0.f;
      for (int t = tid; t < 256 * (qb + 1); t += NWAVES * 64) k2 = fmaxf(k2, kn2[(rowbase + t) * 8 + h]);
#pragma unroll
      for (int o_ = 1; o_ < 64; o_ <<= 1) { q2 = fmaxf(q2, __shfl_xor(q2, o_)); k2 = fmaxf(k2, __shfl_xor(k2, o_)); }
      if (lane == 0) { LAS float* nb = (LAS float*)(lds + MISC_OFF + 128); nb[wid] = q2; nb[8 + wid] = k2; } }
    __syncthreads();
    f32x16 gt;
#pragma unroll
    for (int i = 0; i < 16; ++i) gt[i] = 0.f;
#pragma unroll
    for (int ks = 0; ks < 8; ++ks) { const bf16x8 a = *(const LAS bf16x8*)(KM + r * KP + ks * 16 + hh * 8); gt = MFMA32(a, qf[ks], gt); }
    float sc[16];
#pragma unroll
    for (int i = 0; i < 8; ++i) { const float own = gt[i], oth = get_x32(own, hh); const int blo = 8 * (i >> 2) + (i & 3);
        sc[blo] = hh ? oth : own; sc[blo + 4] = hh ? own : oth; }
    unsigned mask = 0u;
#pragma unroll
    for (int rep = 0; rep < 3; ++rep) { float best = -INFINITY; int bi = -1;
#pragma unroll
        for (int j = 0; j < 16; ++j) { const bool ok = (j < qb) && !((mask >> j) & 1u) && (sc[j] > best); best = ok ? sc[j] : best; bi = ok ? j : bi; }
        if (bi >= 0) mask |= 1u << bi; }
    LBAR();
    const float slope2 = exp2f(-(float)(h + 1)) * LOG2E;
    const float tq_rel = (float)(wid * 32 + r);
    bf16x8 aext0, aext1, bext;
    { const unsigned shi = f2bf(slope2), slo = f2bf(slope2 - bf2f((unsigned short)shi)); const unsigned p0w = f2bf((float)r), p1w = f2bf((float)(32 + r));
      v4u a0 = {0u, 0u, 0u, 0u}, a1 = {0u, 0u, 0u, 0u}, bq = {0u, 0u, 0u, 0u};
      if (hh == 0) { a0.x = p0w | (p0w << 16); a1.x = p1w | (p1w << 16); bq.x = shi | (slo << 16); }
      aext0 = __builtin_bit_cast(bf16x8, a0); aext1 = __builtin_bit_cast(bf16x8, a1); bext = __builtin_bit_cast(bf16x8, bq); }
    float mrun = -1e30f, lrun = 0.f; f32x16 o[4];
#pragma unroll
    for (int dt = 0; dt < 4; ++dt)
#pragma unroll
        for (int i = 0; i < 16; ++i) o[dt][i] = 0.f;
    const int ntile = 4 * (qb + 1);
    v4u kreg[2], vreg[2];
    const char* Kh = (const char*)(K + rowbase * D + h * HD); const char* Vh = (const char*)(V + rowbase * D + h * HD);
    const unsigned goff = (unsigned)(((tid >> 4) * D + 8 * (tid & 15)) * 2);
    const int soffK = (tid >> 4) * KP + 8 * (tid & 15), soffV = (tid >> 4) * VP + 8 * (tid & 15);
#define ATT_LOAD(kt_) do { const char* kb_ = Kh + (size_t)(kt_) * (64 * D * 2); const char* vb_ = Vh + (size_t)(kt_) * (64 * D * 2); \
        kreg[0] = *(const v4u*)(kb_ + goff); kreg[1] = *(const v4u*)(kb_ + goff + 32 * D * 2); vreg[0] = *(const v4u*)(vb_ + goff); vreg[1] = *(const v4u*)(vb_ + goff + 32 * D * 2); } while (0)
#define ATT_WRITE(kslot_, vslot_) do { LAS bf16* ks_ = (LAS bf16*)(lds + LDS_K) + (kslot_) * 64 * KP; LAS bf16* vs_ = (LAS bf16*)(lds + LDS_V) + (vslot_) * 64 * VP; \
        *(LAS v4u*)(ks_ + soffK) = kreg[0]; *(LAS v4u*)(ks_ + soffK + 32 * KP) = kreg[1]; *(LAS v4u*)(vs_ + soffV) = vreg[0]; *(LAS v4u*)(vs_ + soffV + 32 * VP) = vreg[1]; } while (0)
#define ATT_QK(kslot_) do { const LAS bf16* Ks_ = (const LAS bf16*)(lds + LDS_K) + (kslot_) * 64 * KP + r * KP + hh * 8; \
        _Pragma("unroll") for (int i_ = 0; i_ < 16; ++i_) { p0[i_] = 0.f; p1[i_] = 0.f; } \
        p0 = MFMA32(aext0, bext, p0); p1 = MFMA32(aext1, bext, p1); \
        _Pragma("unroll") for (int ks_ = 0; ks_ < 8; ++ks_) { const bf16x8 a0_ = *(const LAS bf16x8*)(Ks_ + ks_ * 16), a1_ = *(const LAS bf16x8*)(Ks_ + 32 * KP + ks_ * 16); \
            const bf16x8 q_ = *(const LAS bf16x8*)(Qs + ks_ * 512); p0 = MFMA32(a0_, q_, p0); p1 = MFMA32(a1_, q_, p1); if ((ks_ & 1) == 1) __builtin_amdgcn_sched_barrier(0); } } while (0)
#define ATT_SM(kt_) do { const int j_ = (kt_) >> 2, tk0_ = 64 * ((kt_) & 3); const bool own_ = (j_ == qb); const bool sel_ = own_ || ((mask >> j_) & 1u); \
        const float cl_ = sel_ ? slope2 * ((float)(256 * (j_ - qb) + tk0_) - tq_rel) : -INFINITY; \
        if (own_ && tk0_ + 63 > wid * 32) { const float kb0_ = (float)(tk0_ + 4 * hh); \
            _Pragma("unroll") for (int i_ = 0; i_ < 16; ++i_) { const float cr_ = (float)((i_ & 3) + 8 * (i_ >> 2)); if (kb0_ + cr_ > tq_rel) p0[i_] = -INFINITY; if (kb0_ + cr_ + 32.f > tq_rel) p1[i_] = -INFINITY; } } \
        float mx_ = -INFINITY; \
        _Pragma("unroll") for (int i_ = 0; i_ < 16; ++i_) mx_ = fmaxf(mx_, fmaxf(p0[i_], p1[i_])); \
        mx_ = max_x32(mx_) + cl_; \
        if (__any(mx_ > mrun + THR)) { const float mnew_ = fmaxf(mrun, mx_); const float alpha_ = __builtin_amdgcn_exp2f(mrun - mnew_); mrun = mnew_; lrun *= alpha_; \
            _Pragma("unroll") for (int dt_ = 0; dt_ < 4; ++dt_) _Pragma("unroll") for (int i_ = 0; i_ < 16; ++i_) o[dt_][i_] *= alpha_; } \
        const float off_ = mrun - cl_; float rs_ = 0.f; \
        _Pragma("unroll") for (int i_ = 0; i_ < 16; ++i_) { p0[i_] = __builtin_amdgcn_exp2f(p0[i_] - off_); p1[i_] = __builtin_amdgcn_exp2f(p1[i_] - off_); rs_ += p0[i_] + p1[i_]; } \
        lrun += rs_; \
        _Pragma("unroll") for (int s_ = 0; s_ < 2; ++s_) { v4u w0_, w1_; \
            w0_.x = cvtpk(p0[8 * s_ + 0], p0[8 * s_ + 1]); w0_.y = cvtpk(p0[8 * s_ + 2], p0[8 * s_ + 3]); w0_.z = cvtpk(p0[8 * s_ + 4], p0[8 * s_ + 5]); w0_.w = cvtpk(p0[8 * s_ + 6], p0[8 * s_ + 7]); \
            w1_.x = cvtpk(p1[8 * s_ + 0], p1[8 * s_ + 1]); w1_.y = cvtpk(p1[8 * s_ + 2], p1[8 * s_ + 3]); w1_.z = cvtpk(p1[8 * s_ + 4], p1[8 * s_ + 5]); w1_.w = cvtpk(p1[8 * s_ + 6], p1[8 * s_ + 7]); \
            pb[0][s_] = __builtin_bit_cast(bf16x8, w0_); pb[1][s_] = __builtin_bit_cast(bf16x8, w1_); } } while (0)
#define ATT_PV(vslot_) do { const LAS bf16* vb_ = (const LAS bf16*)(lds + LDS_V) + (vslot_) * 64 * VP + vlane; \
        _Pragma("unroll") for (int dt_ = 0; dt_ < 4; ++dt_) { \
            _Pragma("unroll") for (int kh_ = 0; kh_ < 2; ++kh_) _Pragma("unroll") for (int s_ = 0; s_ < 2; ++s_) { const LAS bf16* vp_ = vb_ + (32 * kh_ + 16 * s_) * VP + 32 * dt_; \
                const s16x4 lo_ = vtr(vp_), hi_ = vtr(vp_ + 8 * VP); const bf16x8 a_ = __builtin_shufflevector(lo_, hi_, 0, 1, 2, 3, 4, 5, 6, 7); o[dt_] = MFMA32(a_, pb[kh_][s_], o[dt_]); } \
            __builtin_amdgcn_sched_barrier(0); } } while (0)
    const int vlane = (4 * hh + ((lane & 15) >> 2)) * VP + 16 * ((lane >> 4) & 1) + 4 * (lane & 3);
    const bool late = wid >= 4;
    f32x16 p0, p1; bf16x8 pb[2][2]; bool pend = false; int vs_prev = 0;
    int kt0 = 0; { const LAS float* nb = (const LAS float*)(lds + MISC_OFF + 128); float q2 = 0.f, k2 = 0.f;
#pragma unroll
        for (int w_ = 0; w_ < 8; ++w_) { q2 = fmaxf(q2, nb[w_]); k2 = fmaxf(k2, nb[8 + w_]); }
        const float D0 = (151.f + 2.f * sqrtf(q2 * k2) * 1.01f) / slope2; const float first = (256.f * qb - D0 - 63.f) * (1.f / 64.f); if (first > 0.f) kt0 = (int)first; if (kt0 > 4 * qb) kt0 = 4 * qb; }
    ATT_LOAD(kt0);
    int ksl = 0, vsl = 0;
    for (int kt = kt0; kt < ntile; ++kt) {
        ATT_WRITE(ksl, vsl);
        LBAR();
        if (kt + 1 < ntile) ATT_LOAD(kt + 1);
        const int j = kt >> 2; const bool own = (j == qb); const bool sel = own || ((mask >> j) & 1u);
        const bool skip = (__ballot(sel) == 0ull) || (own && 64 * (kt & 3) > wid * 32 + 31);
        if (pend) { ATT_PV(vs_prev); pend = false; }
        if (!skip) { ATT_QK(ksl); ATT_SM(kt);
            if (late) { pend = true; vs_prev = vsl; } else ATT_PV(vsl); }
        ksl ^= 1; vsl = (vsl == 2) ? 0 : vsl + 1;
    }
    if (pend) ATT_PV(vs_prev);
#undef ATT_LOAD
#undef ATT_WRITE
#undef ATT_QK
#undef ATT_SM
#undef ATT_PV
    lrun = sum_x32(lrun);
    const float inv = 1.f / lrun;
    bf16* orow = O + (rowbase + qb * 256 + wid * 32 + r) * D + h * HD + 4 * hh;
#pragma unroll
    for (int dt = 0; dt < 4; ++dt)
#pragma unroll
        for (int g = 0; g < 4; ++g) { u32x2 w; w.x = cvtpk(o[dt][4 * g] * inv, o[dt][4 * g + 1] * inv); w.y = cvtpk(o[dt][4 * g + 2] * inv, o[dt][4 * g + 3] * inv);
            *(u32x2*)(orow + 32 * dt + 8 * g) = w; }
    __syncthreads();
}
DI void attn_phase(Frame& F, const bf16* Q, const bf16* K, const bf16* V, const float* kpart, const float* kn2, bf16* O) {
    volatile LAS int* slot = (volatile LAS int*)(F.lds + MISC_OFF + 64);
    for (;;) {
        if (F.tid == 0) slot[0] = (int)__hip_atomic_fetch_add((unsigned*)(F.ctl + CW_ATTQ), 1u, __ATOMIC_RELAXED, __HIP_MEMORY_SCOPE_AGENT);
        __syncthreads();
        const int u = slot[0];
        if (u >= BATCH * H * 16) break;
        const int qb = 15 - (u >> 6), h = 7 - ((u >> 3) & 7), b = u & 7;
        attn_unit(b, h, qb, Q, K, V, kpart, kn2, O, F.lds, F.tid);
    }
}
}

#ifndef USE_REF_DELTA
#define USE_REF_DELTA 0
#endif
#ifndef MK_ONE_LAUNCH
#define MK_ONE_LAUNCH 1
#endif
#if USE_REF_DELTA
__global__ void __launch_bounds__(512) ref_conv(const bf16* q0, const bf16* k0, const bf16* v0, const float* conv_w, bf16* outc) {
    const int m = blockIdx.x / 3, ts = blockIdx.x % 3, tid = threadIdx.x, t = m % T;
    const bf16* src = ts == 0 ? q0 : ts == 1 ? k0 : v0;
    float y[2];
#pragma unroll
    for (int e = 0; e < 2; ++e) { const int c = 2 * tid + e; float a = 0.f;
#pragma unroll
        for (int j = 0; j < 4; ++j) { const int tt = t - 3 + j; if (tt >= 0) a += conv_w[(size_t)j * 3 * D + ts * D + c] * bf2f(src[(size_t)(m - 3 + j) * D + c]); }
        y[e] = siluf_(a); }
    if (ts < 2) { const float ss = wave_sum(y[0] * y[0] + y[1] * y[1]); float rn = rsqrtf(ss + 1e-6f); if (ts == 0) rn *= 0.08838834764831845f; y[0] *= rn; y[1] *= rn; }
    *(unsigned*)(outc + (size_t)ts * M * D + (size_t)m * D + 2 * tid) = cvtpk(y[0], y[1]);
}
__global__ void __launch_bounds__(256) ref_delta(const bf16* qkvc, const bf16* z, const float* beta, const float* gl, const float* out_g, bf16* a0) {
    __shared__ float ks[128], qs[128], red[2][128], red2[2][128], wsum[2];
    const int b = blockIdx.x >> 3, h = blockIdx.x & 7, tid = threadIdx.x, dvi = tid & 127, half = tid >> 7;
    const bf16* qc = qkvc + h * HD; const bf16* kc = qkvc + (size_t)M * D + h * HD; const bf16* vc = qkvc + 2 * (size_t)M * D + h * HD;
    float S[64];
#pragma unroll
    for (int i = 0; i < 64; ++i) S[i] = 0.f;
    const float og = out_g[dvi];
    for (int t = 0; t < T; ++t) {
        const size_t m = (size_t)b * T + t;
        if (tid < 128) ks[tid] = bf2f(kc[m * D + tid]); else qs[tid - 128] = bf2f(qc[m * D + tid - 128]);
        const float v = bf2f(vc[m * D + dvi]); const float bt = beta[m * 8 + h], eg = __expf(gl[m * 8 + h]);
        __syncthreads();
        float part = 0.f;
#pragma unroll
        for (int i = 0; i < 64; ++i) { S[i] *= eg; part += ks[half * 64 + i] * S[i]; }
        red[half][dvi] = part;
        __syncthreads();
        const float delta = bt * (v - (red[0][dvi] + red[1][dvi]));
        float po = 0.f;
#pragma unroll
        for (int i = 0; i < 64; ++i) { S[i] += ks[half * 64 + i] * delta; po += qs[half * 64 + i] * S[i]; }
        red2[half][dvi] = po;
        __syncthreads();
        float o = 0.f;
        if (half == 0) { o = red2[0][dvi] + red2[1][dvi]; const float ss = wave_sum(o * o); if ((tid & 63) == 0) wsum[tid >> 6] = ss; }
        __syncthreads();
        if (half == 0) { const float rstd = rsqrtf((wsum[0] + wsum[1]) * (1.f / HD) + RMS_EPS); const float zz = bf2f(z[m * D + h * HD + dvi]);
            a0[m * D + h * HD + dvi] = (bf16)f2bf(o * rstd * og * siluf_(zz)); }
    }
}
DI void p2_chunks(Frame&) {}
DI void p3_scan(Frame& F) { p0b_layer1_weights(F, F.vcu, F.G); }
DI void p3b_gate(Frame& F) { GAS v4u* z4 = (GAS v4u*)(F.ws + WS_BETA); for (int e = F.vcu * (NWAVES * 64) + F.tid; e < M * 8 / 4; e += F.G * NWAVES * 64) z4[e] = (v4u){0u, 0u, 0u, 0u}; }
#endif

#if !USE_REF_DELTA
namespace p2 {
constexpr int KP = 136, TP = 72, AP = 68;
constexpr int L_KN = 0, L_QN = 17408, L_RT = 34816, L_KDT = 71680, L_AM = 90112, L_TM = 107520, L_TB = 124928, L_AT = 134144, L_GC = 143360, L_CW = 144384, L_END = 150528;
static_assert(L_END <= MISC_OFF, "P2 LDS");
struct Raw { v4u r[3][5]; float g, bt; };
DI void decode(int q, int& b, int& h, int& n) { h = q & 7; b = (q >> 3) & 7; n = q >> 6; }
DI void load_raw_part(Frame& F, int q, Raw& R, const int part) {
    int b, h, n; decode(q, b, h, n);
    const int tid = F.tid, grp = tid >> 4, cl = tid & 15, t0 = n * CL;
    const bf16* qk0 = (const bf16*)(F.ws + WS_Q0); const bf16* v0 = (const bf16*)((const unsigned char*)F.out + 64 * MiB);
#pragma unroll
    for (int ts = 0; ts < 3; ++ts) { const bf16* src = (ts < 2 ? qk0 + (size_t)ts * M * D : v0) + (size_t)b * T * D;
        const __amdgpu_buffer_rsrc_t rs = __builtin_amdgcn_make_buffer_rsrc((void*)src, 0, T * D * 2, 0x00020000);
#pragma unroll
        for (int j = 0; j < 5; ++j) { if (((ts * 5 + j) < 8) != (part == 0)) continue;
            const int tt = t0 + 2 * grp - 3 + j;
            R.r[ts][j] = __builtin_amdgcn_raw_buffer_load_b128(rs, (unsigned)((tt * D + h * HD + 8 * cl) * 2), 0, 0); } }
}
DI void load_gbt(Frame& F, int q, Raw& R) {
    int b, h, n; decode(q, b, h, n);
    const size_t m0 = (size_t)b * T + (size_t)n * CL; R.g = ((const float*)(F.ws + WS_G))[(m0 + F.lane) * 8 + h]; R.bt = ((const float*)(F.ws + WS_BETA))[(m0 + F.lane) * 8 + h];
}
DI void p2_run(Frame& F, const int p, const int NP) {
    const __amdgpu_buffer_rsrc_t crs = __builtin_amdgcn_make_buffer_rsrc((void*)(F.ws + WS_CH), 0, (int)((size_t)BATCH * H * NCH * CH_BYTES), 0x00020000);
    unsigned* const flags = (unsigned*)(F.ctl + CW_FLAG);
    const bool fast = F.fast;
#define P2_ST128(v_, off_) do { if (fast) __builtin_amdgcn_raw_buffer_store_b128(v_, crs, off_, 0, 0); else __builtin_amdgcn_raw_buffer_store_b128(v_, crs, off_, 0, 16); } while (0)
#define P2_ST64(v_, off_) do { if (fast) __builtin_amdgcn_raw_buffer_store_b64(v_, crs, off_, 0, 0); else __builtin_amdgcn_raw_buffer_store_b64(v_, crs, off_, 0, 16); } while (0)
    int pend = -1; bool first = true;
    const int tid = F.tid, lane = F.lane, wave = F.wave, fr = lane & 15, fq = lane >> 4;
    LAS bf16* KN = (LAS bf16*)(F.lds + L_KN); LAS bf16* QN = (LAS bf16*)(F.lds + L_QN); LAS bf16* RT = (LAS bf16*)(F.lds + L_RT); LAS bf16* KDT = (LAS bf16*)(F.lds + L_KDT);
    LAS float* AM = (LAS float*)(F.lds + L_AM); LAS float* TM = (LAS float*)(F.lds + L_TM); LAS bf16* TB = (LAS bf16*)(F.lds + L_TB); LAS bf16* AT = (LAS bf16*)(F.lds + L_AT);
    LAS float* GC = (LAS float*)(F.lds + L_GC);
    LAS float* CW = (LAS float*)(F.lds + L_CW);
    int hprev = -1;
    Raw R;
#define P2_STEP_A(q_) do { int b_, h_, n_; decode((q_), b_, h_, n_); float g = R.g; \
        _Pragma("unroll") for (int o = 1; o < 64; o <<= 1) { const float t = __shfl_up(g, o); if (lane >= o) g += t; } \
        const float gl = __shfl(g, 63); \
        GC[lane] = g; GC[64 + lane] = __expf(g); GC[128 + lane] = __expf(gl - g); GC[192 + lane] = R.bt; \
        if (lane == 63) __hip_atomic_store((float*)(F.ws + WS_GTOT) + (b_ * H + h_) * NCH + n_, __expf(g), __ATOMIC_RELAXED, __HIP_MEMORY_SCOPE_AGENT); } while (0)
    if (p < BATCH * H * NCH) { load_raw_part(F, p, R, 0); load_raw_part(F, p, R, 1); if (wave == 1) { load_gbt(F, p, R); P2_STEP_A(p); } }
    for (int e = tid; e < 64 * TP / 8; e += NWAVES * 64) *(LAS v4u*)(TB + 8 * e) = (v4u){0u, 0u, 0u, 0u};
    LBAR();
#pragma unroll 1
    for (int q = p; q < BATCH * H * NCH; q += NP) {
    int b, h, n; decode(q, b, h, n);
    const int item = (b * H + h) * NCH + n;
    const unsigned cho = (unsigned)item * (unsigned)CH_BYTES;
    if (h != hprev) {
        float cwv[3];
#pragma unroll
        for (int j = 0; j < 3; ++j) { const int e = tid + j * NWAVES * 64, ts = e >> 9, jt = (e >> 7) & 3, c = e & 127; cwv[j] = F.dn_conv_w[(size_t)jt * 3 * D + ts * D + h * HD + c]; }
#pragma unroll
        for (int j = 0; j < 3; ++j) CW[tid + j * NWAVES * 64] = cwv[j];
        hprev = h;
        LBAR();
    }
    {
        const int grp = tid >> 4, cl = tid & 15, tk0 = 2 * grp;
        const int tpos = (((tk0 >> 3) ^ (cl & 7)) << 3) + (tk0 & 7);
#pragma unroll
        for (int ts = 0; ts < 3; ++ts) {
            float y[2][8];
#pragma unroll
            for (int it = 0; it < 2; ++it) {
#pragma unroll
                for (int e = 0; e < 8; ++e) y[it][e] = 0.f;
#pragma unroll
                for (int j = 0; j < 4; ++j) { const v4u raw = R.r[ts][it + j]; const f32x4 wa = *(const LAS f32x4*)(CW + (ts * 4 + j) * 128 + 8 * cl), wb = *(const LAS f32x4*)(CW + (ts * 4 + j) * 128 + 8 * cl + 4);
                    y[it][0] += wa[0] * __uint_as_float(raw.x << 16); y[it][1] += wa[1] * __uint_as_float(raw.x & 0xffff0000u);
                    y[it][2] += wa[2] * __uint_as_float(raw.y << 16); y[it][3] += wa[3] * __uint_as_float(raw.y & 0xffff0000u);
                    y[it][4] += wb[0] * __uint_as_float(raw.z << 16); y[it][5] += wb[1] * __uint_as_float(raw.z & 0xffff0000u);
                    y[it][6] += wb[2] * __uint_as_float(raw.w << 16); y[it][7] += wb[3] * __uint_as_float(raw.w & 0xffff0000u); }
                float ss = 0.f;
#pragma unroll
                for (int e = 0; e < 8; ++e) { y[it][e] = siluf_(y[it][e]); ss += y[it][e] * y[it][e]; }
                if (ts < 2) {
#define P2_ROR_ADD(n_) ss += __builtin_bit_cast(float, __builtin_amdgcn_update_dpp(0, __builtin_bit_cast(int, ss), 0x120 + (n_), 0xF, 0xF, false))
                    P2_ROR_ADD(8); P2_ROR_ADD(4); P2_ROR_ADD(2); P2_ROR_ADD(1);
#undef P2_ROR_ADD
                    float rn = rsqrtf(ss + 1e-6f); if (ts == 0) rn *= 0.08838834764831845f;
#pragma unroll
                    for (int e = 0; e < 8; ++e) y[it][e] *= rn; }
            }
            const float eg0 = GC[64 + tk0], eg1 = GC[65 + tk0], ek0 = GC[128 + tk0], ek1 = GC[129 + tk0], bt0 = GC[192 + tk0], bt1 = GC[193 + tk0];
            if (ts == 0) {
#pragma unroll
                for (int it = 0; it < 2; ++it) { const float eg = it ? eg1 : eg0; const int tk = tk0 + it;
                    v4u a; a.x = cvtpk(y[it][0], y[it][1]); a.y = cvtpk(y[it][2], y[it][3]); a.z = cvtpk(y[it][4], y[it][5]); a.w = cvtpk(y[it][6], y[it][7]);
                    *(LAS v4u*)(QN + tk * KP + 8 * cl) = a;
                    v4u d; d.x = cvtpk(y[it][0] * eg, y[it][1] * eg); d.y = cvtpk(y[it][2] * eg, y[it][3] * eg); d.z = cvtpk(y[it][4] * eg, y[it][5] * eg); d.w = cvtpk(y[it][6] * eg, y[it][7] * eg);
                    P2_ST128(d, cho + (unsigned)(CH_QD + (tk * 128 + 8 * cl) * 2)); }
            } else if (ts == 1) {
#pragma unroll
                for (int it = 0; it < 2; ++it) { const int tk = tk0 + it;
                    v4u a; a.x = cvtpk(y[it][0], y[it][1]); a.y = cvtpk(y[it][2], y[it][3]); a.z = cvtpk(y[it][4], y[it][5]); a.w = cvtpk(y[it][6], y[it][7]);
                    *(LAS v4u*)(KN + tk * KP + 8 * cl) = a; }
                const float be0 = bt0 * eg0, be1 = bt1 * eg1;
#pragma unroll
                for (int e = 0; e < 8; ++e) { *(LAS unsigned*)(KDT + (8 * cl + e) * TP + tpos) = cvtpk(y[0][e] * ek0, y[1][e] * ek1); *(LAS unsigned*)(RT + (128 + 8 * cl + e) * TP + tpos) = cvtpk(y[0][e] * be0, y[1][e] * be1); }
            } else {
#pragma unroll
                for (int e = 0; e < 8; ++e) *(LAS unsigned*)(RT + (8 * cl + e) * TP + tpos) = cvtpk(y[0][e] * bt0, y[1][e] * bt1);
            }
        }
    }
    asm volatile("s_waitcnt vmcnt(2)" ::: "memory");
    LBAR();
    if (pend >= 0 && tid == 0) __hip_atomic_store(flags + pend, 1u, __ATOMIC_RELAXED, __HIP_MEMORY_SCOPE_AGENT);
    const bool has_next = q + NP < BATCH * H * NCH;
    if (has_next && wave == 1) load_gbt(F, q + NP, R);
    {
        int zz = 0; asm volatile("" : "+v"(zz));
        const int fr = (lane & 15) + zz, fq = (lane >> 4) + zz;
        const int mat = wave >> 2, rt = wave & 3; const LAS bf16* As = mat ? QN : KN;
        const f32x4 gi = *(const LAS f32x4*)(GC + 16 * rt + 4 * fq), bi = *(const LAS f32x4*)(GC + 192 + 16 * rt + 4 * fq);
        float gj[4];
#pragma unroll
        for (int ct = 0; ct < 4; ++ct) gj[ct] = GC[16 * ct + fr];
        bf16x8 af[4];
#pragma unroll
        for (int ks = 0; ks < 4; ++ks) af[ks] = *(const LAS bf16x8*)(As + (16 * rt + fr) * KP + 32 * ks + 8 * fq);
#pragma unroll
        for (int cp = 0; cp < 2; ++cp) {
            if (has_next) load_raw_part(F, q + NP, R, cp);
            bf16x8 bfr[2][4]; f32x4 acc[2];
#pragma unroll
            for (int c2 = 0; c2 < 2; ++c2)
#pragma unroll
                for (int ks = 0; ks < 4; ++ks) bfr[c2][ks] = *(const LAS bf16x8*)(KN + (16 * (2 * cp + c2) + fr) * KP + 32 * ks + 8 * fq);
#pragma unroll
            for (int c2 = 0; c2 < 2; ++c2) { acc[c2] = (f32x4){0.f, 0.f, 0.f, 0.f};
#pragma unroll
                for (int ks = 0; ks < 4; ++ks) acc[c2] = MFMA16(af[ks], bfr[c2][ks], acc[c2]); }
            if (mat == 0) {
#pragma unroll
                for (int c2 = 0; c2 < 2; ++c2) { const int ct = 2 * cp + c2, j = 16 * ct + fr;
#pragma unroll
                    for (int rg = 0; rg < 4; ++rg) { const int i = 16 * rt + 4 * fq + rg; const float dec = __expf(fminf(gi[rg] - gj[ct], 0.f));
                        AM[i * AP + j] = (i > j) ? bi[rg] * acc[c2][rg] * dec : 0.f; } }
            } else {
#pragma unroll
                for (int c2 = 0; c2 < 2; ++c2) { const int ct = 2 * cp + c2, j = 16 * ct + fr;
#pragma unroll
                    for (int rg = 0; rg < 4; ++rg) { const int i = 16 * rt + 4 * fq + rg; const float dec = __expf(fminf(gi[rg] - gj[ct], 0.f));
                        AT[i * TP + j] = f2bfq((i >= j) ? acc[c2][rg] * dec : 0.f); } }
            }
            __builtin_amdgcn_sched_barrier(0);
        }
    }
    LBAR();
    if (wave == 0) {
        const int blk = lane >> 4, c = lane & 15; float tc[16];
#pragma unroll
        for (int r = 0; r < 16; ++r) { float t = (r == c) ? 1.f : 0.f; const LAS float* ar = AM + (16 * blk + r) * AP + 16 * blk;
#pragma unroll
            for (int j4 = 0; j4 < (r + 3) / 4; ++j4) { const f32x4 a = *(const LAS f32x4*)(ar + 4 * j4);
#pragma unroll
                for (int e = 0; e < 4; ++e) if (4 * j4 + e < r) t -= a[e] * tc[4 * j4 + e]; }
            tc[r] = t; }
#pragma unroll
        for (int r = 0; r < 16; ++r) { TM[(16 * blk + r) * AP + 16 * blk + c] = tc[r]; TB[(16 * blk + r) * TP + 16 * blk + c] = f2bfq(tc[r]); }
    } else if (wave == 1) {
        if (has_next) P2_STEP_A(q + NP);
    } else if (wave >= 4) {
        int zz = 0; asm volatile("" : "+v"(zz));
        const int t2 = tid - 256 + zz;
#pragma unroll
        for (int e = 0; e < 2; ++e) { const int pp = t2 + 256 * e, row = pp >> 3, c8 = pp & 7; P2_ST128(*(const LAS v4u*)(AT + row * TP + 8 * c8), cho + (unsigned)(CH_AT + (row * 64 + 8 * c8) * 2)); }
#pragma unroll
        for (int e = 0; e < 4; ++e) { const int idx = t2 + 256 * e, r2 = idx >> 3, c2 = idx & 7; P2_ST128(*(const LAS v4u*)(KDT + r2 * TP + ((c2 ^ ((r2 >> 3) & 7)) << 3)), cho + (unsigned)(CH_KD + (r2 * 64 + 8 * c2) * 2)); }
    }
    LBAR();
    if (wave < 3) { const int j = wave;
        int zz = 0; asm volatile("" : "+v"(zz));
        const int fr = (lane & 15) + zz, fq = (lane >> 4) + zz;
        f32x4 aik[4][3], tii[4]; float tjj[4];
#pragma unroll
        for (int i = 1; i < 4; ++i) { tii[i] = *(const LAS f32x4*)(TM + (16 * i + fr) * AP + 16 * i + 4 * fq);
#pragma unroll
            for (int k = 0; k < 3; ++k) if (k < i) aik[i][k] = *(const LAS f32x4*)(AM + (16 * i + fr) * AP + 16 * k + 4 * fq); }
#pragma unroll
        for (int rho = 0; rho < 4; ++rho) tjj[rho] = TM[(16 * j + 4 * fq + rho) * AP + 16 * j + fr];
        f32x4 tk[4];
#pragma unroll
        for (int k = 0; k < 4; ++k) tk[k] = (f32x4){0.f, 0.f, 0.f, 0.f};
#pragma unroll
        for (int i = 1; i < 4; ++i) { if (i > j) { f32x4 x = {0.f, 0.f, 0.f, 0.f};
#pragma unroll
                for (int k = 0; k < 3; ++k) { if (k < i && k >= j) {
#pragma unroll
                        for (int rho = 0; rho < 4; ++rho) x = __builtin_amdgcn_mfma_f32_16x16x4f32(aik[i][k][rho], (k == j) ? tjj[rho] : tk[k][rho], x, 0, 0, 0); } }
                f32x4 y = {0.f, 0.f, 0.f, 0.f};
#pragma unroll
                for (int rho = 0; rho < 4; ++rho) y = __builtin_amdgcn_mfma_f32_16x16x4f32(tii[i][rho], x[rho], y, 0, 0, 0);
                tk[i] = -y;
#pragma unroll
                for (int rg = 0; rg < 4; ++rg) TB[(16 * i + 4 * fq + rg) * TP + 16 * j + fr] = f2bfq(tk[i][rg]); } }
    }
    LBAR();
    {
        int zz = 0; asm volatile("" : "+v"(zz));
        const int fr = (lane & 15) + zz, fq = (lane >> 4) + zz;
        if (wave < 4) { const int rt = wave; bf16x8 a[2], bb[8][2];
#pragma unroll
            for (int ks = 0; ks < 2; ++ks) a[ks] = *(const LAS bf16x8*)(TB + (16 * rt + fr) * TP + 32 * ks + 8 * fq);
#pragma unroll
            for (int ct = 0; ct < 8; ++ct) { const int sw = (2 * ct + (fr >> 3)) & 7;
#pragma unroll
                for (int ks = 0; ks < 2; ++ks) bb[ct][ks] = *(const LAS bf16x8*)(RT + (16 * ct + fr) * TP + (((4 * ks + fq) ^ sw) << 3)); }
#pragma unroll
            for (int ct = 0; ct < 8; ++ct) { f32x4 acc = {0.f, 0.f, 0.f, 0.f}; acc = MFMA16(a[0], bb[ct][0], acc); acc = MFMA16(a[1], bb[ct][1], acc);
                u32x2 o; o.x = cvtpk(acc[0], acc[1]); o.y = cvtpk(acc[2], acc[3]);
                P2_ST64(o, cho + (unsigned)(CH_U + ((16 * ct + fr) * 64 + 16 * rt + 4 * fq) * 2)); }
        } else { const int w4 = wave - 4; bf16x8 bt[4][2], a[2][2];
#pragma unroll
            for (int rt = 0; rt < 4; ++rt)
#pragma unroll
                for (int ks = 0; ks < 2; ++ks) bt[rt][ks] = *(const LAS bf16x8*)(TB + (16 * rt + fr) * TP + 32 * ks + 8 * fq);
#pragma unroll
            for (int c2 = 0; c2 < 2; ++c2) { const int ct = 2 * w4 + c2, sw = (2 * ct + (fr >> 3)) & 7;
#pragma unroll
                for (int ks = 0; ks < 2; ++ks) a[c2][ks] = *(const LAS bf16x8*)(RT + (128 + 16 * ct + fr) * TP + (((4 * ks + fq) ^ sw) << 3)); }
#pragma unroll
            for (int c2 = 0; c2 < 2; ++c2) { const int ct = 2 * w4 + c2;
#pragma unroll
                for (int rt = 0; rt < 4; ++rt) { f32x4 acc = {0.f, 0.f, 0.f, 0.f}; acc = MFMA16(a[c2][0], bt[rt][0], acc); acc = MFMA16(a[c2][1], bt[rt][1], acc);
                    u32x2 o; o.x = cvtpk(-acc[0], -acc[1]); o.y = cvtpk(-acc[2], -acc[3]);
                    P2_ST64(o, cho + (unsigned)(CH_W + ((16 * rt + fr) * 128 + 16 * ct + 4 * fq) * 2)); } }
        }
    }
    LBAR();
    if (first) {
        asm volatile("s_waitcnt vmcnt(0)" ::: "memory");
        LBAR();
        if (tid == 0) __hip_atomic_store(flags + item, 1u, __ATOMIC_RELAXED, __HIP_MEMORY_SCOPE_AGENT);
        first = false;
    } else pend = item;
    }
    asm volatile("s_waitcnt vmcnt(0)" ::: "memory");
    LBAR();
    if (pend >= 0 && tid == 0) __hip_atomic_store(flags + pend, 1u, __ATOMIC_RELAXED, __HIP_MEMORY_SCOPE_AGENT);
#undef P2_STEP_A
#undef P2_ST128
#undef P2_ST64
}
}

namespace p3 {
constexpr int WP = 136, TP = 72;
constexpr int O_W = 0, O_QD = 17408, O_KD = 34816, O_AT = 53248, OPB = 62464, L_OB = 2 * OPB, OBB = 17408, L_END = L_OB + 2 * OBB;
static_assert(L_END + 512 <= MISC_OFF, "P3 LDS");
DI int pi32(int x) { return (x & ~12) | ((x & 4) << 1) | ((x & 8) >> 1); }
DI bf16x8 pack8(const f32x16& x, int s) { v4u w; w.x = cvtpk(x[8 * s], x[8 * s + 1]); w.y = cvtpk(x[8 * s + 2], x[8 * s + 3]); w.z = cvtpk(x[8 * s + 4], x[8 * s + 5]); w.w = cvtpk(x[8 * s + 6], x[8 * s + 7]); return __builtin_bit_cast(bf16x8, w); }
DI void scan_item(Frame& F, int item) {
    const int tid = F.tid, lane = F.lane, wave = F.wave;
    const int h = item & 7, b = item >> 3;
    const unsigned char* chbase = F.ws + WS_CH + (size_t)item * NCH * CH_BYTES;
    float* gtot = (float*)(F.ws + WS_GTOT) + item * NCH;
    unsigned* const fl = (unsigned*)(F.ctl + CW_FLAG) + item * NCH;
    int ready = -1;
#define P3_POLL(nn) do { if ((nn) > ready) { int cnt_; \
            for (;;) { const unsigned f_ = __hip_atomic_load(fl + lane, __ATOMIC_RELAXED, __HIP_MEMORY_SCOPE_AGENT); const unsigned long long nr_ = ~(__ballot(f_ != 0u) >> (nn)); \
                cnt_ = nr_ ? __builtin_ctzll(nr_) : NCH - (nn); if (cnt_ > 0) break; __builtin_amdgcn_s_sleep(2); } \
            ready = (nn) + cnt_ - 1; if (!F.fast) __builtin_amdgcn_fence(__ATOMIC_ACQUIRE, "agent"); asm volatile("" ::: "memory"); } } while (0)
    LAS unsigned char* lds = F.lds;
    LAS float* const GTL = (LAS float*)(lds + MISC_OFF) + 32;
    if (wave < 4) {
        const int rho = lane & 31, hh = lane >> 5, c0 = 32 * wave, prow = pi32(rho);
        f32x16 S[4];
#pragma unroll
        for (int t = 0; t < 4; ++t)
#pragma unroll
            for (int i = 0; i < 16; ++i) S[t][i] = 0.f;
        v4u ucur[2][2];
        LBAR();
        { const bf16* up = (const bf16*)(chbase + CH_U) + (c0 + rho) * 64 + 8 * hh;
#pragma unroll
          for (int r = 0; r < 2; ++r)
#pragma unroll
              for (int s = 0; s < 2; ++s) ucur[r][s] = *(const v4u*)(up + 32 * r + 16 * s); }
        LBAR();
#pragma unroll 1
        for (int n = 0; n < NCH; ++n) {
            const LAS bf16* Wl = (const LAS bf16*)(lds + (n & 1) * OPB + O_W) + prow * WP + 8 * hh; const LAS bf16* QDl = (const LAS bf16*)(lds + (n & 1) * OPB + O_QD) + rho * WP + 8 * hh;
            const LAS bf16* KDl = (const LAS bf16*)(lds + (n & 1) * OPB + O_KD) + prow * TP + 8 * hh; const LAS bf16* ATl = (const LAS bf16*)(lds + (n & 1) * OPB + O_AT) + rho * TP + 8 * hh;
            LAS bf16* OBl = (LAS bf16*)(lds + L_OB + (n & 1) * OBB);
            const float gt = __uint_as_float(__builtin_amdgcn_readfirstlane(__float_as_uint(GTL[n & 1])));
            f32x16 vn[2], o[2];
#pragma unroll
            for (int r = 0; r < 2; ++r) {
#pragma unroll
                for (int s = 0; s < 2; ++s) { const v4u q = ucur[r][s];
                    vn[r][8 * s + 0] = __uint_as_float(q.x << 16); vn[r][8 * s + 1] = __uint_as_float(q.x & 0xffff0000u); vn[r][8 * s + 2] = __uint_as_float(q.y << 16); vn[r][8 * s + 3] = __uint_as_float(q.y & 0xffff0000u);
                    vn[r][8 * s + 4] = __uint_as_float(q.z << 16); vn[r][8 * s + 5] = __uint_as_float(q.z & 0xffff0000u); vn[r][8 * s + 6] = __uint_as_float(q.w << 16); vn[r][8 * s + 7] = __uint_as_float(q.w & 0xffff0000u); }
#pragma unroll
                for (int i = 0; i < 16; ++i) o[r][i] = 0.f; }
            asm volatile("" : "+v"(vn[0]), "+v"(vn[1]) :: "memory");
            if (n + 1 < NCH) { const bf16* up = (const bf16*)(chbase + (size_t)(n + 1) * CH_BYTES + CH_U) + (c0 + rho) * 64 + 8 * hh;
#pragma unroll
                for (int r = 0; r < 2; ++r)
#pragma unroll
                    for (int s = 0; s < 2; ++s) ucur[r][s] = *(const v4u*)(up + 32 * r + 16 * s); }
#define SB() __builtin_amdgcn_sched_barrier(0)
            bf16x8 fa[8], fb[8];
#define P3_LDF(dst, t) do { _Pragma("unroll") for (int s_ = 0; s_ < 2; ++s_) { dst[4 * s_ + 0] = *(const LAS bf16x8*)(Wl + 32 * (t) + 16 * s_); dst[4 * s_ + 1] = *(const LAS bf16x8*)(Wl + 32 * WP + 32 * (t) + 16 * s_); \
                dst[4 * s_ + 2] = *(const LAS bf16x8*)(QDl + 32 * (t) + 16 * s_); dst[4 * s_ + 3] = *(const LAS bf16x8*)(QDl + 32 * WP + 32 * (t) + 16 * s_); } } while (0)
#define P3_MM8(f, t) do { _Pragma("unroll") for (int s_ = 0; s_ < 2; ++s_) { const bf16x8 sb_ = pack8(S[t], s_); vn[0] = MFMA32(f[4 * s_ + 0], sb_, vn[0]); vn[1] = MFMA32(f[4 * s_ + 1], sb_, vn[1]); o[0] = MFMA32(f[4 * s_ + 2], sb_, o[0]); o[1] = MFMA32(f[4 * s_ + 3], sb_, o[1]); } } while (0)
            P3_LDF(fa, 0); SB();
            P3_LDF(fb, 1); SB(); P3_MM8(fa, 0); SB();
            P3_LDF(fa, 2); SB(); P3_MM8(fb, 1); SB();
            P3_LDF(fb, 3); SB(); P3_MM8(fa, 2); SB();
            fa[0] = *(const LAS bf16x8*)(ATl); fa[1] = *(const LAS bf16x8*)(ATl + 16); fa[2] = *(const LAS bf16x8*)(ATl + 32 * TP); fa[3] = *(const LAS bf16x8*)(ATl + 32 * TP + 16);
            fa[4] = *(const LAS bf16x8*)(ATl + 32 * TP + 32); fa[5] = *(const LAS bf16x8*)(ATl + 32 * TP + 48); fa[6] = *(const LAS bf16x8*)(KDl); fa[7] = *(const LAS bf16x8*)(KDl + 16);
            SB(); P3_MM8(fb, 3); SB();
#undef P3_LDF
#undef P3_MM8
            bf16x8 vnb[2][2];
#pragma unroll
            for (int r = 0; r < 2; ++r)
#pragma unroll
                for (int s = 0; s < 2; ++s) vnb[r][s] = pack8(vn[r], s);
            fb[0] = *(const LAS bf16x8*)(KDl + 32); fb[1] = *(const LAS bf16x8*)(KDl + 48);
#pragma unroll
            for (int e = 0; e < 4; ++e) fb[2 + e] = *(const LAS bf16x8*)(KDl + 32 * TP + 16 * e);
            fb[6] = *(const LAS bf16x8*)(KDl + 64 * TP); fb[7] = *(const LAS bf16x8*)(KDl + 64 * TP + 16);
            SB();
            o[0] = MFMA32(fa[0], vnb[0][0], o[0]); o[1] = MFMA32(fa[2], vnb[0][0], o[1]); o[0] = MFMA32(fa[1], vnb[0][1], o[0]); o[1] = MFMA32(fa[3], vnb[0][1], o[1]);
            o[1] = MFMA32(fa[4], vnb[1][0], o[1]); o[1] = MFMA32(fa[5], vnb[1][1], o[1]);
#pragma unroll
            for (int i = 0; i < 16; ++i) S[0][i] *= gt;
            S[0] = MFMA32(fa[6], vnb[0][0], S[0]); S[0] = MFMA32(fa[7], vnb[0][1], S[0]);
            SB();
            fa[0] = *(const LAS bf16x8*)(KDl + 64 * TP + 32); fa[1] = *(const LAS bf16x8*)(KDl + 64 * TP + 48);
#pragma unroll
            for (int e = 0; e < 4; ++e) fa[2 + e] = *(const LAS bf16x8*)(KDl + 96 * TP + 16 * e);
            SB();
            S[0] = MFMA32(fb[0], vnb[1][0], S[0]); S[0] = MFMA32(fb[1], vnb[1][1], S[0]);
#pragma unroll
            for (int i = 0; i < 16; ++i) S[1][i] *= gt;
            S[1] = MFMA32(fb[2], vnb[0][0], S[1]); S[1] = MFMA32(fb[3], vnb[0][1], S[1]); S[1] = MFMA32(fb[4], vnb[1][0], S[1]); S[1] = MFMA32(fb[5], vnb[1][1], S[1]);
#pragma unroll
            for (int i = 0; i < 16; ++i) S[2][i] *= gt;
            S[2] = MFMA32(fb[6], vnb[0][0], S[2]); S[2] = MFMA32(fb[7], vnb[0][1], S[2]);
            SB();
            S[2] = MFMA32(fa[0], vnb[1][0], S[2]); S[2] = MFMA32(fa[1], vnb[1][1], S[2]);
#pragma unroll
            for (int i = 0; i < 16; ++i) S[3][i] *= gt;
            S[3] = MFMA32(fa[2], vnb[0][0], S[3]); S[3] = MFMA32(fa[3], vnb[0][1], S[3]); S[3] = MFMA32(fa[4], vnb[1][0], S[3]); S[3] = MFMA32(fa[5], vnb[1][1], S[3]);
#undef SB
#pragma unroll
            for (int rp = 0; rp < 2; ++rp)
#pragma unroll
                for (int i = 0; i < 16; ++i) OBl[(32 * rp + (i & 3) + 8 * (i >> 2) + 4 * hh) * WP + c0 + rho] = f2bfq(o[rp][i]);
            LBAR();
        }
    } else {
        const int lt = tid - 256;
        const int etok = lt >> 2, eq = lt & 3;
        LAS float* OG = (LAS float*)(lds + L_END);
        if (lt < 128) OG[lt] = F.dn_out_g[lt];
        bf16* const za = (bf16*)F.out;
        struct OpRegs { v4u w[4], q[4], k[4], a[2]; float g; };
        OpRegs RA; v4u zr[4], zn[4];
#define P3_LDG16(dst_, ptr_) asm volatile("global_load_dwordx4 %0, %1, off" : "=v"(dst_) : "v"(ptr_) : "memory")
#define P3_WAITV(n_) asm volatile("s_waitcnt vmcnt(" #n_ ")" ::: "memory")
#define P3_WAITR(cnt_, full_) asm volatile("s_waitcnt vmcnt(" #cnt_ ")\n\ts_cmp_lg_u32 %[f], 0\n\ts_cbranch_scc0 1f\n\ts_waitcnt vmcnt(0)\n1:" : "+v"(RA.w[0]), "+v"(RA.w[1]), "+v"(RA.w[2]), "+v"(RA.w[3]), \
            "+v"(RA.q[0]), "+v"(RA.q[1]), "+v"(RA.q[2]), "+v"(RA.q[3]), "+v"(RA.k[0]), "+v"(RA.k[1]), "+v"(RA.k[2]), "+v"(RA.k[3]), "+v"(RA.a[0]), "+v"(RA.a[1]), "+v"(RA.g) : [f] "s"(full_) : "scc", "memory")
#define P3_WAITZ(cnt_, full_) asm volatile("s_waitcnt vmcnt(" #cnt_ ")\n\ts_cmp_lg_u32 %[f], 0\n\ts_cbranch_scc0 1f\n\ts_waitcnt vmcnt(0)\n1:" : "+v"(zn[0]), "+v"(zn[1]), "+v"(zn[2]), "+v"(zn[3]) : [f] "s"(full_) : "scc", "memory")
#define P3_LOAD(R_, nn) do { const unsigned char* cb_ = chbase + (size_t)(nn) * CH_BYTES; \
            _Pragma("unroll") for (int e_ = 0; e_ < 4; ++e_) { const int idx_ = lt + 256 * e_; P3_LDG16(R_.w[e_], cb_ + CH_W + (size_t)idx_ * 16); P3_LDG16(R_.q[e_], cb_ + CH_QD + (size_t)idx_ * 16); P3_LDG16(R_.k[e_], cb_ + CH_KD + (size_t)idx_ * 16); } \
            _Pragma("unroll") for (int e_ = 0; e_ < 2; ++e_) { const int idx_ = lt + 256 * e_; P3_LDG16(R_.a[e_], cb_ + CH_AT + (size_t)idx_ * 16); } \
            asm volatile("global_load_dword %0, %1, off sc1" : "=v"(R_.g) : "v"(gtot + (nn)) : "memory"); } while (0)
#define P3_WRITE(R_, bufi) do { LAS unsigned char* ob_ = lds + (bufi) * OPB; \
            _Pragma("unroll") for (int e_ = 0; e_ < 4; ++e_) { const int idx_ = lt + 256 * e_; *(LAS v4u*)(ob_ + O_W + ((idx_ >> 4) * WP + 8 * (idx_ & 15)) * 2) = R_.w[e_]; *(LAS v4u*)(ob_ + O_QD + ((idx_ >> 4) * WP + 8 * (idx_ & 15)) * 2) = R_.q[e_]; \
                *(LAS v4u*)(ob_ + O_KD + ((idx_ >> 3) * TP + 8 * (idx_ & 7)) * 2) = R_.k[e_]; } \
            _Pragma("unroll") for (int e_ = 0; e_ < 2; ++e_) { const int idx_ = lt + 256 * e_; *(LAS v4u*)(ob_ + O_AT + ((idx_ >> 3) * TP + 8 * (idx_ & 7)) * 2) = R_.a[e_]; } \
            if (lt == 0) GTL[bufi] = R_.g; } while (0)
#define P3_ZLOAD(nn) do { const size_t m_ = (size_t)b * T + (size_t)(nn) * CL + etok; _Pragma("unroll") for (int e_ = 0; e_ < 4; ++e_) P3_LDG16(zn[e_], za + m_ * D + h * HD + 32 * eq + 8 * e_); } while (0)
#define P3_EPI(nn) do { const LAS bf16* ob_ = (const LAS bf16*)(lds + L_OB + ((nn) & 1) * OBB) + etok * WP + 32 * eq; const size_t m_ = (size_t)b * T + (size_t)(nn) * CL + etok; \
            float ss_ = 0.f; \
            _Pragma("unroll") for (int e_ = 0; e_ < 4; ++e_) { const v4u ov_ = *(const LAS v4u*)(ob_ + 8 * e_); const unsigned ow_[4] = {ov_.x, ov_.y, ov_.z, ov_.w}; \
                _Pragma("unroll") for (int k_ = 0; k_ < 4; ++k_) { const float lo_ = __uint_as_float(ow_[k_] << 16), hi_ = __uint_as_float(ow_[k_] & 0xffff0000u); ss_ += lo_ * lo_ + hi_ * hi_; } } \
            ss_ += __shfl_xor(ss_, 1); ss_ += __shfl_xor(ss_, 2); const float rs_ = rsqrtf(ss_ * (1.f / HD) + RMS_EPS); \
            _Pragma("unroll") for (int e_ = 0; e_ < 4; ++e_) { const v4u ov_ = *(const LAS v4u*)(ob_ + 8 * e_); const unsigned ow_[4] = {ov_.x, ov_.y, ov_.z, ov_.w}, zw_[4] = {zr[e_].x, zr[e_].y, zr[e_].z, zr[e_].w}; \
                const f32x4 g0_ = *(const LAS f32x4*)(OG + 32 * eq + 8 * e_), g1_ = *(const LAS f32x4*)(OG + 32 * eq + 8 * e_ + 4); const float gg_[8] = {g0_[0], g0_[1], g0_[2], g0_[3], g1_[0], g1_[1], g1_[2], g1_[3]}; \
                float r_[8]; _Pragma("unroll") for (int k_ = 0; k_ < 4; ++k_) { \
                    r_[2 * k_] = __uint_as_float(ow_[k_] << 16) * rs_ * gg_[2 * k_] * siluf_(__uint_as_float(zw_[k_] << 16)); \
                    r_[2 * k_ + 1] = __uint_as_float(ow_[k_] & 0xffff0000u) * rs_ * gg_[2 * k_ + 1] * siluf_(__uint_as_float(zw_[k_] & 0xffff0000u)); } \
                v4u w_; w_.x = cvtpk(r_[0], r_[1]); w_.y = cvtpk(r_[2], r_[3]); w_.z = cvtpk(r_[4], r_[5]); w_.w = cvtpk(r_[6], r_[7]); *(v4u*)(za + m_ * D + h * HD + 32 * eq + 8 * e_) = w_; } } while (0)
        P3_POLL(0);
        LBAR();
        P3_LOAD(RA, 0); P3_WAITR(0, 0); P3_WRITE(RA, 0); asm volatile("" ::: "memory");
        P3_POLL(1);
        P3_LOAD(RA, 1);
        LBAR();
#pragma unroll 1
        for (int n = 0; n < NCH; ++n) {
            P3_ZLOAD(n);
            if (n + 1 < NCH) { P3_WAITR(8, __builtin_amdgcn_readfirstlane(n < 2 ? 1 : 0));
                P3_WRITE(RA, (n + 1) & 1); }
            asm volatile("" ::: "memory");
            if (n + 2 < NCH) { P3_POLL(n + 2); P3_LOAD(RA, n + 2); }
            if (n >= 1) P3_EPI(n - 1);
            P3_WAITZ(19, __builtin_amdgcn_readfirstlane((n >= 1 && n + 2 < NCH) ? 0 : 1));
#pragma unroll
            for (int e = 0; e < 4; ++e) zr[e] = zn[e];
            LBAR();
        }
        P3_EPI(NCH - 1);
#undef P3_LDG16
#undef P3_WAITV
#undef P3_WAITR
#undef P3_WAITZ
#undef P3_LOAD
#undef P3_WRITE
#undef P3_EPI
#undef P3_ZLOAD
    }
    LBAR();
#undef P3_POLL
}
}
DI void zero_kn2(Frame& F) { GAS v4u* z4 = (GAS v4u*)(F.ws + WS_BETA); for (int e = F.vcu * (NWAVES * 64) + F.tid; e < M * 8 / 4; e += F.G * NWAVES * 64) z4[e] = (v4u){0u, 0u, 0u, 0u}; }
DI void p23_delta(Frame& F) {
    const int NSCAN = F.G >= 2 * BATCH * H ? BATCH * H : (F.G > 1 ? F.G / 2 : 1), bx = (int)blockIdx.x;
    if (F.G < 2) return;
    const bool lightw = (NSCAN == BATCH * H) && (F.G - NSCAN == 192);
    if (bx < NSCAN) { if (!lightw) { p0b_layer1_weights(F, bx, NSCAN); __syncthreads(); }
#pragma unroll 1
        for (int item = bx; item < BATCH * H; item += NSCAN) { int t_ = F.tid; asm volatile("" : "+v"(t_)); t_ &= NWAVES * 64 - 1;
            Frame F2 = F; F2.tid = t_; F2.lane = t_ & 63; p3::scan_item(F2, item); } }
    else { p2::p2_run(F, bx - NSCAN, F.G - NSCAN);
        if (lightw && bx - NSCAN >= 64) { __syncthreads(); p0b_layer1_weights(F, bx - NSCAN - 64, 128); } }
}
#endif

struct Args { const float* in[14]; float* out; unsigned char* ws; int ph_lo, ph_hi, var, pad; };
static_assert(sizeof(Args) == 14 * 8 + 8 + 8 + 16, "Args has no padding");
constexpr int N_PHASES = 14;
#ifndef STAG_UP
#define STAG_UP 800
#endif
#ifndef REP_LIST
#define REP_LIST {1,1,1,1,1,1,1,1,1,1,1,1,1,1}
#endif
constexpr int REP[14] = REP_LIST;
#ifndef HREP_LIST
#define HREP_LIST {1,1,1,1,1,1,1,1,1,1,1,1,1,1}
#endif
static const int HREP[14] = HREP_LIST;
__global__ void __launch_bounds__(NWAVES * 64, 2) fwd(Args args) {
    extern __shared__ __attribute__((aligned(16))) unsigned char lds_raw[];
    Frame F;
    F.lds = (LAS unsigned char*)lds_raw;
    F.MISC = (volatile LAS unsigned*)(F.lds + MISC_OFF);
    F.tid = threadIdx.x; F.lane = F.tid & 63; F.wave = __builtin_amdgcn_readfirstlane(F.tid >> 6);
    F.G = gridDim.x; { const int bx = blockIdx.x; F.vcu = (F.G % 8 == 0) ? (bx % 8) * (F.G / 8) + bx / 8 : bx; }
    F.ws = args.ws; F.ctl = (gu32*)(args.ws + WS_CTL); F.out = args.out;
    F.x = args.in[0]; F.mix_g = args.in[1]; F.mlp_g = args.in[2]; F.dn_w_in = args.in[3]; F.dn_conv_w = args.in[4]; F.dn_a_log = args.in[5]; F.dn_dt_bias = args.in[6];
    F.dn_out_g = args.in[7]; F.dn_w_out = args.in[8]; F.mb_w_in = args.in[9]; F.mb_w_out = args.in[10]; F.w_up = args.in[11]; F.w_down = args.in[12]; F.final_g = args.in[13];
    for (int u = F.tid; u < (LDS_BYTES - MISC_OFF) / 4; u += NWAVES * 64) ((LAS unsigned*)(F.lds + MISC_OFF))[u] = 0u;
    __syncthreads();
    const int lo = args.ph_lo, hi = args.ph_hi; F.var = args.var;
    const bool multi = (hi - lo) > 1;
    XcdBarrier bar; bar.bar = (unsigned*)(F.ctl + CW_BAR); bar.x = 0; bar.st = nullptr;
    F.fast = false;
    if (multi) { bar = xcd_barrier_post((unsigned*)(F.ctl + CW_BAR), F.MISC + 8);
        if (F.tid == 0 && (bar.x != ((unsigned)blockIdx.x & 7u) || (gridDim.x & 7u) != 0u)) atomicOr((unsigned*)(F.ctl + CW_MAPBAD), 1u); }
    bool fm_known = false;
#define IN(k) (lo <= (k) && (k) < hi)
#define SEAM(k) do { if (IN(k) && IN((k) + 1)) { xcd_barrier(bar); if (!fm_known) { fm_known = true; F.fast = __builtin_amdgcn_readfirstlane((int)xb_ld((unsigned*)(F.ctl + CW_MAPBAD))) == 0; } } } while (0)
    unsigned char* const ws = args.ws;
    bf16* const Q0 = (bf16*)(ws + WS_Q0); bf16* const XB = (bf16*)(ws + WS_K0); bf16* const CHB = (bf16*)(ws + WS_CH);
    bf16* const Zb = (bf16*)args.out; bf16* const V0 = (bf16*)((unsigned char*)args.out + 64 * MiB);
    float* const ssq = (float*)(ws + WS_SSQ); constexpr size_t SSQ_STRIDE = (size_t)M * 16;
    float* const kpart = (float*)(ws + WS_KPART);

    if (IN(0)) for (int rep_ = 0; rep_ < REP[0]; ++rep_) { p0_prologue(F); } SEAM(0);
    if (IN(1)) for (int rep_ = 0; rep_ < REP[1]; ++rep_) {
        pg8::Gemm g{CHB, (const bf16*)(ws + WS_WDNIN), M, 4 * D, D}; pg8::StaticOrder S; S.init(M, 4 * D, F.G, (int)blockIdx.x);
        EpiDnIn E{Q0, Zb};
        pg8::gemm_phase<EpiDnIn, pg8::StaticOrder, true, true>(F.lds, g, S, E);
        p1_beta_g(F);
    } SEAM(1);
    if (IN(2)) for (int rep_ = 0; rep_ < REP[2]; ++rep_) { p23_delta(F); }
    if (IN(2) && IN(5)) xcd_barrier(bar);
    if (IN(5)) for (int rep_ = 0; rep_ < REP[5]; ++rep_) {
        zero_kn2(F);
        pg8::Gemm g{Zb, (const bf16*)(ws + WS_WDNOUT), M, D, D}; pg8::StaticOrder S; S.init(M, D, F.G, (int)blockIdx.x);
        EpiResid E{F.x, XB, ssq + 0 * SSQ_STRIDE};
        pg8::gemm_phase<EpiResid, pg8::StaticOrder, true, true>(F.lds, g, S, E);
    } SEAM(5);
    if (IN(6)) for (int rep_ = 0; rep_ < REP[6]; ++rep_) {
        pg8::Gemm g{XB, (const bf16*)(ws + WS_WUP0), M, FF, D}; pg8::StaticOrder S; S.init(M, FF, F.G, (int)blockIdx.x);
        fill_rtab(F, S, ssq + 0 * SSQ_STRIDE); EpiUp E{CHB, (const LAS float*)(F.lds + RTAB_OFF)};
        pg8::gemm_phase<EpiUp, pg8::StaticOrder, true, true>(F.lds, g, S, E);
    } SEAM(6);
    if (IN(7)) for (int rep_ = 0; rep_ < REP[7]; ++rep_) {
        pg8::Gemm g{CHB, (const bf16*)(ws + WS_WDOWN0), M, D, FF}; pg8::StaticOrder S; S.init(M, D, F.G, (int)blockIdx.x);
        EpiResid E{nullptr, XB, ssq + 1 * SSQ_STRIDE};
        pg8::gemm_phase<EpiResid, pg8::StaticOrder, true, true>(F.lds, g, S, E);
    } SEAM(7);
    bf16* const Q1 = CHB; bf16* const K1 = (bf16*)(ws + WS_CH + 64 * MiB); bf16* const V1 = (bf16*)(ws + WS_CH + 128 * MiB);
    if (IN(8)) for (int rep_ = 0; rep_ < REP[8]; ++rep_) {
        pg8::Gemm g{XB, (const bf16*)(ws + WS_WMBIN), M, NMB, D}; pg8::StaticOrder S; S.init(M, NMB, F.G, (int)blockIdx.x);
        fill_rtab(F, S, ssq + 1 * SSQ_STRIDE); EpiMbIn E{Q1, kpart, (const LAS float*)(F.lds + RTAB_OFF), (float*)(ws + WS_BETA)};
        pg8::gemm_phase<EpiMbIn, pg8::StaticOrder, true, true>(F.lds, g, S, E);
    } SEAM(8);
    if (IN(9)) for (int rep_ = 0; rep_ < REP[9]; ++rep_) { attn::attn_phase(F, Q1, K1, V1, kpart, (const float*)(ws + WS_BETA), Q0); } SEAM(9);
    if (IN(10)) for (int rep_ = 0; rep_ < REP[10]; ++rep_) {
        pg8::Gemm g{Q0, (const bf16*)(ws + WS_WMBOUT), M, D, D}; pg8::StaticOrder S; S.init(M, D, F.G, (int)blockIdx.x);
        EpiResid E{nullptr, XB, ssq + 2 * SSQ_STRIDE};
        pg8::gemm_phase<EpiResid, pg8::StaticOrder, true, true>(F.lds, g, S, E);
    } SEAM(10);
    if (IN(11)) for (int rep_ = 0; rep_ < REP[11]; ++rep_) {
        pg8::Gemm g{XB, (const bf16*)(ws + WS_WUP1), M, FF, D}; pg8::StaticOrder S; S.init(M, FF, F.G, (int)blockIdx.x);
        fill_rtab(F, S, ssq + 2 * SSQ_STRIDE); EpiUp E{CHB, (const LAS float*)(F.lds + RTAB_OFF)};
        pg8::gemm_phase<EpiUp, pg8::StaticOrder, true, true>(F.lds, g, S, E);
    } SEAM(11);
    if (IN(12)) for (int rep_ = 0; rep_ < REP[12]; ++rep_) {
        pg8::Gemm g{CHB, (const bf16*)(ws + WS_WDOWN1), M, D, FF}; pg8::StaticOrder S; S.init(M, D, F.G, (int)blockIdx.x);
        EpiResid E{nullptr, XB, ssq + 3 * SSQ_STRIDE};
        pg8::gemm_phase<EpiResid, pg8::StaticOrder, true, true>(F.lds, g, S, E);
    } SEAM(12);
    if (IN(13)) for (int rep_ = 0; rep_ < REP[13]; ++rep_) { p_final(F); }
#undef IN
#undef SEAM
}

extern "C" void kernel_launch(void* const* d_in, const int* in_sizes, int n_in, void* d_out, int out_size, void* d_ws, size_t ws_size, hipStream_t stream) {
    static int grid = 0;
    if (grid == 0) {
        if (n_in != 14 || in_sizes[0] != M * D || out_size != M * D || ws_size < WS_END) { fprintf(stderr, "kernel_launch: unexpected shapes (n_in %d, in0 %d, out %d, ws %zu)\n", n_in, n_in > 0 ? in_sizes[0] : -1, out_size, ws_size); grid = -1; return; }
        int dev = 0, cus = 0, per_cu = 0;
        if (hipGetDevice(&dev) != hipSuccess || hipDeviceGetAttribute(&cus, hipDeviceAttributeMultiprocessorCount, dev) != hipSuccess) { grid = -1; return; }
        if (hipFuncSetAttribute((const void*)fwd, hipFuncAttributeMaxDynamicSharedMemorySize, LDS_BYTES) != hipSuccess) { fprintf(stderr, "kernel_launch: hipFuncSetAttribute failed\n"); grid = -1; return; }
        if (hipOccupancyMaxActiveBlocksPerMultiprocessor(&per_cu, (const void*)fwd, NWAVES * 64, LDS_BYTES) != hipSuccess || per_cu < 1) fprintf(stderr, "kernel_launch: occupancy query says %d\n", per_cu);
        (void)hipGetLastError();
        grid = cus;
    }
    if (grid < 0) return;
    (void)hipMemsetAsync((char*)d_ws + WS_CTL, 0, CTL_ZERO_BYTES, stream);
    Args a{};
    for (int i = 0; i < 14; ++i) a.in[i] = (const float*)d_in[i];
    a.out = (float*)d_out; a.ws = (unsigned char*)d_ws;
#if MK_ONE_LAUNCH
    a.ph_lo = 0; a.ph_hi = N_PHASES;
    hipLaunchKernelGGL(fwd, dim3(grid), dim3(NWAVES * 64), LDS_BYTES, stream, a);
#else
    for (int ph = 0; ph < N_PHASES; ++ph) {
#if USE_REF_DELTA
        if (ph == 2) { hipLaunchKernelGGL(ref_conv, dim3(M * 3), dim3(512), 0, stream, (const bf16*)((char*)d_ws + WS_Q0), (const bf16*)((char*)d_ws + WS_K0), (const bf16*)((char*)d_out + 64 * MiB),
                                          (const float*)d_in[4], (bf16*)((char*)d_ws + WS_CH)); continue; }
        if (ph == 3) { hipLaunchKernelGGL(ref_delta, dim3(BATCH * H), dim3(256), 0, stream, (const bf16*)((char*)d_ws + WS_CH), (const bf16*)d_out, (const float*)((char*)d_ws + WS_BETA), (const float*)((char*)d_ws + WS_G),
                                          (const float*)d_in[7], (bf16*)((char*)d_ws + WS_Q0)); continue; }
#endif
        a.ph_lo = ph; a.ph_hi = ph + 1;
#ifdef PROBE_PHASE
        if (ph == PROBE_PHASE) { a.var = PROBE_VAR; hipLaunchKernelGGL(fwd, dim3(grid), dim3(NWAVES * 64), LDS_BYTES, stream, a); a.var = 0; }
#endif
        for (int r_ = 0; r_ < HREP[ph]; ++r_) hipLaunchKernelGGL(fwd, dim3(grid), dim3(NWAVES * 64), LDS_BYTES, stream, a);
    }
#endif
}
```
